# Optimizing an MI355X kernel written in HIP

```python
import jax
import jax.numpy as jnp
from jax import lax
import numpy as np


D_MODEL = 2048
BATCH = 4
SEQ = 4096
DEPTH = 1

N_ATTN_HEADS = 8
ATTN_HEAD_DIM = 128
ATTN_WIDTH = N_ATTN_HEADS * ATTN_HEAD_DIM
MOBA_BLOCK = 256
MOBA_TOPK = 3
MOBA_Q_CHUNK = 16
RET_HEADS = 4
RET_HEAD_DIM = 256
RET_WIDTH = RET_HEADS * RET_HEAD_DIM
RET_CHUNK = 128
MIX_WIDTH = ATTN_WIDTH + RET_WIDTH
IN_WIDTH = 3 * ATTN_WIDTH + 4 * RET_WIDTH
N_GROUPS = 4
EXPERTS_PER_GROUP = 8
N_EXPERTS = N_GROUPS * EXPERTS_PER_GROUP
INNER_TOP_K = 2
D_EXPERT = 512
MOE_ROW_BLOCK = 128
N_MOD = 6
NORM_EPS = 1e-6
F32 = jnp.float32

kernel_name = 'hymba_moba_retnet_hmoe_block'


def rmsnorm(x, w):
    xf = x.astype(F32)
    y = xf * lax.rsqrt(jnp.mean(xf * xf, axis=-1, keepdims=True) + NORM_EPS)
    return (y * w.astype(F32)).astype(x.dtype)


def modulate(h, shift, scale):
    return h * (1 + scale[:, None, :]) + shift[:, None, :]


def split_heads(z, n_heads, head_dim):
    b, t, _ = z.shape
    return z.reshape(b, t, n_heads, head_dim).transpose(0, 2, 1, 3)


def merge_heads(z):
    b, h, t, dh = z.shape
    return z.transpose(0, 2, 1, 3).reshape(b, t, h * dh)


def moba_attention(q, k, v):
    b, h, t, dh = q.shape
    nb = -(-t // MOBA_BLOCK)
    tp = nb * MOBA_BLOCK
    pad = ((0, 0), (0, 0), (0, tp - t), (0, 0))
    k_p = jnp.pad(k, pad)
    v_p = jnp.pad(v, pad)
    kb = k_p.reshape(b, h, nb, MOBA_BLOCK, dh)
    vb = v_p.reshape(b, h, nb, MOBA_BLOCK, dh)
    k_mean = jnp.mean(kb.astype(F32), axis=3)
    q_block = jnp.arange(t) // MOBA_BLOCK
    past = jnp.arange(nb)[None, :] < q_block[:, None]
    gate = jnp.einsum('bhtd,bhnd->bhtn', q.astype(F32), k_mean)
    gate = jnp.where(past[None, None], gate, -jnp.inf)
    n_sel = min(MOBA_TOPK, nb)
    gate_top, sel = lax.top_k(gate, n_sel)
    valid = jnp.isfinite(gate_top)
    slopes = jnp.exp2(-8.0 * jnp.arange(1, h + 1, dtype=F32) / h)
    scale = dh ** -0.5
    b_idx = jnp.arange(b)[:, None, None, None]
    h_idx = jnp.arange(h)[None, :, None, None]
    offs = jnp.arange(MOBA_BLOCK)
    n_keys_sel = n_sel * MOBA_BLOCK

    def chunk(ci):
        t0 = ci * MOBA_Q_CHUNK
        qc = lax.dynamic_slice_in_dim(q, t0, MOBA_Q_CHUNK, axis=2)
        sel_c = lax.dynamic_slice_in_dim(sel, t0, MOBA_Q_CHUNK, axis=2)
        valid_c = lax.dynamic_slice_in_dim(valid, t0, MOBA_Q_CHUNK, axis=2)
        tq_i = t0 + jnp.arange(MOBA_Q_CHUNK)
        tq = tq_i.astype(F32)
        k_sel = kb[b_idx, h_idx, sel_c]
        v_sel = vb[b_idx, h_idx, sel_c]
        s_sel = jnp.einsum('bhqd,bhqjsd->bhqjs', qc, k_sel).astype(F32) * scale
        pos_sel = (sel_c[..., None] * MOBA_BLOCK + offs).astype(F32)
        s_sel = s_sel - slopes[None, :, None, None, None] * (tq[None, None, :, None, None] - pos_sel)
        s_sel = jnp.where(valid_c[..., None], s_sel, -jnp.inf).reshape(b, h, MOBA_Q_CHUNK, n_keys_sel)
        b0 = (t0 // MOBA_BLOCK) * MOBA_BLOCK
        k_own = lax.dynamic_slice_in_dim(k_p, b0, MOBA_BLOCK, axis=2)
        v_own = lax.dynamic_slice_in_dim(v_p, b0, MOBA_BLOCK, axis=2)
        pos_own = b0 + offs
        s_own = jnp.einsum('bhqd,bhsd->bhqs', qc, k_own).astype(F32) * scale
        s_own = s_own - slopes[None, :, None, None] * (tq[:, None] - pos_own.astype(F32)[None, :])[None, None]
        causal = pos_own[None, :] <= tq_i[:, None]
        s_own = jnp.where(causal[None, None], s_own, -jnp.inf)
        logits = jnp.concatenate([s_sel, s_own], axis=-1)
        p = jax.nn.softmax(logits, axis=-1).astype(v.dtype)
        out = jnp.einsum('bhqs,bhqsd->bhqd', p[..., :n_keys_sel],
                         v_sel.reshape(b, h, MOBA_Q_CHUNK, n_keys_sel, dh))
        out = out + jnp.einsum('bhqs,bhsd->bhqd', p[..., n_keys_sel:], v_own)
        return out

    out = lax.map(chunk, jnp.arange(t // MOBA_Q_CHUNK))
    return out.transpose(1, 2, 0, 3, 4).reshape(b, h, t, dh)


def multiscale_retention(q, k, v):
    b, h, t, dk = q.shape
    dv = v.shape[-1]
    n = t // RET_CHUNK
    dt = q.dtype
    log_gamma = jnp.log1p(-jnp.exp2(-5.0 - jnp.arange(h, dtype=F32)))
    pos = jnp.arange(RET_CHUNK, dtype=F32)
    diff = pos[:, None] - pos[None, :]
    decay_mask = jnp.where(diff >= 0, jnp.exp(jnp.maximum(diff, 0.0) * log_gamma[:, None, None]), 0.0).astype(dt)
    k_decay = jnp.exp((RET_CHUNK - 1 - pos) * log_gamma[:, None]).astype(dt)
    q_decay = jnp.exp((pos + 1) * log_gamma[:, None]).astype(dt)
    chunk_decay = jnp.exp(RET_CHUNK * log_gamma)
    qc = q.reshape(b, h, n, RET_CHUNK, dk)
    kc = (k * (dk ** -0.5)).reshape(b, h, n, RET_CHUNK, dk)
    vc = v.reshape(b, h, n, RET_CHUNK, dv)
    scores = jnp.einsum('bhnid,bhnjd->bhnij', qc, kc) * decay_mask[None, :, None]
    inner = jnp.einsum('bhnij,bhnje->bhnie', scores, vc)
    chunk_kv = jnp.einsum('bhnjd,bhnje->nbhde', kc * k_decay[None, :, None, :, None], vc).astype(F32)

    def step(state, kv_n):
        return state * chunk_decay[None, :, None, None] + kv_n, state

    _, state_prev = lax.scan(step, jnp.zeros((b, h, dk, dv), F32), chunk_kv)
    cross = jnp.einsum('bhnid,nbhde->bhnie', qc, state_prev.astype(dt)) * q_decay[None, :, None, :, None]
    return (inner + cross).reshape(b, h, t, dv)


def grouped_expert_ffn(hf, expert_id, weights, w1, w3, w2):
    n, d = hf.shape
    eid = expert_id.reshape(-1)
    tok = jnp.repeat(jnp.arange(n, dtype=jnp.int32), expert_id.shape[1])
    wts = weights.reshape(-1)
    a = eid.shape[0]
    p_rows = a + N_EXPERTS * MOE_ROW_BLOCK
    n_blk = p_rows // MOE_ROW_BLOCK
    order = jnp.argsort(eid)
    eid_s = eid[order]
    counts = jnp.bincount(eid, length=N_EXPERTS)
    starts = jnp.cumsum(counts) - counts
    padded = (counts + MOE_ROW_BLOCK - 1) // MOE_ROW_BLOCK * MOE_ROW_BLOCK
    pad_end = jnp.cumsum(padded)
    pad_start = pad_end - padded
    dest = pad_start[eid_s] + jnp.arange(a) - starts[eid_s]
    row_tok = jnp.zeros((p_rows,), jnp.int32).at[dest].set(tok[order])
    row_w = jnp.zeros((p_rows,), wts.dtype).at[dest].set(wts[order])
    blk_expert = jnp.minimum(jnp.searchsorted(pad_end, jnp.arange(n_blk) * MOE_ROW_BLOCK, side='right'), N_EXPERTS - 1)

    def block_ffn(args):
        rows, e = args
        xb = hf[rows]
        return (jax.nn.silu(xb @ w1[e]) * (xb @ w3[e])) @ w2[e]

    y_rows = lax.map(block_ffn, (row_tok.reshape(n_blk, MOE_ROW_BLOCK), blk_expert))
    y_rows = y_rows.reshape(p_rows, d) * row_w[:, None]
    return jax.ops.segment_sum(y_rows, row_tok, num_segments=n)


def hier_moe(h, w_group, b_group, w_router, b_router, w1, w3, w2):
    b, t, d = h.shape
    n = b * t
    hf = h.reshape(n, d)
    g_prob = jax.nn.softmax((hf @ w_group + b_group).astype(F32), axis=-1)
    g_sel = jnp.argmax(g_prob, axis=-1)
    g_w = jnp.take_along_axis(g_prob, g_sel[:, None], axis=1)
    e_logits = jnp.einsum('nd,gde->nge', hf, w_router) + b_router
    e_logits = jnp.take_along_axis(e_logits, g_sel[:, None, None], axis=1)[:, 0]
    e_prob = jax.nn.softmax(e_logits.astype(F32), axis=-1)
    top_p, top_e = lax.top_k(e_prob, INNER_TOP_K)
    weights = g_w * top_p / jnp.sum(top_p, axis=-1, keepdims=True)
    expert_id = g_sel[:, None] * EXPERTS_PER_GROUP + top_e
    y = grouped_expert_ffn(hf, expert_id, weights.astype(h.dtype), w1, w3, w2)
    return y.reshape(b, t, d)


def setup_inputs(seed: int = 0) -> dict:
    key = jax.random.key(seed)
    ks = jax.random.split(key, 17)
    nrm = jax.random.normal
    return {
        'x': nrm(ks[0], (BATCH, SEQ, D_MODEL), F32),
        'c': nrm(ks[1], (BATCH, D_MODEL), F32),
        'w_ada': nrm(ks[2], (DEPTH, D_MODEL, N_MOD * D_MODEL), F32) * D_MODEL ** -0.5,
        'b_ada': nrm(ks[3], (DEPTH, N_MOD * D_MODEL), F32) * 0.01,
        'norm_mix_w': 1.0 + 0.02 * nrm(ks[4], (DEPTH, D_MODEL), F32),
        'w_in': nrm(ks[5], (DEPTH, D_MODEL, IN_WIDTH), F32) * D_MODEL ** -0.5,
        'ret_norm_w': 1.0 + 0.02 * nrm(ks[6], (DEPTH, RET_WIDTH), F32),
        'w_out': nrm(ks[7], (DEPTH, MIX_WIDTH, D_MODEL), F32) * MIX_WIDTH ** -0.5,
        'norm_ffn_w': 1.0 + 0.02 * nrm(ks[8], (DEPTH, D_MODEL), F32),
        'w_group': nrm(ks[9], (DEPTH, D_MODEL, N_GROUPS), F32) * D_MODEL ** -0.5,
        'b_group': nrm(ks[10], (DEPTH, N_GROUPS), F32) * 0.01,
        'w_router': nrm(ks[11], (DEPTH, N_GROUPS, D_MODEL, EXPERTS_PER_GROUP), F32) * D_MODEL ** -0.5,
        'b_router': nrm(ks[12], (DEPTH, N_GROUPS, EXPERTS_PER_GROUP), F32) * 0.01,
        'w1': nrm(ks[13], (DEPTH, N_EXPERTS, D_MODEL, D_EXPERT), F32) * D_MODEL ** -0.5,
        'w3': nrm(ks[14], (DEPTH, N_EXPERTS, D_MODEL, D_EXPERT), F32) * D_MODEL ** -0.5,
        'w2': nrm(ks[15], (DEPTH, N_EXPERTS, D_EXPERT, D_MODEL), F32) * D_EXPERT ** -0.5,
        'norm_final_w': 1.0 + 0.02 * nrm(ks[16], (D_MODEL,), F32),
    }


def reference(x, c, w_ada, b_ada, norm_mix_w, w_in, ret_norm_w, w_out, norm_ffn_w,
              w_group, b_group, w_router, b_router, w1, w3, w2, norm_final_w):
    b, t, d = x.shape
    c_act = jax.nn.silu(c)
    splits = [ATTN_WIDTH, 2 * ATTN_WIDTH, 3 * ATTN_WIDTH,
              3 * ATTN_WIDTH + RET_WIDTH, 3 * ATTN_WIDTH + 2 * RET_WIDTH, 3 * ATTN_WIDTH + 3 * RET_WIDTH]
    for l in range(DEPTH):
        mod = c_act @ w_ada[l] + b_ada[l]
        shift_m, scale_m, gate_m, shift_f, scale_f, gate_f = jnp.split(mod, N_MOD, axis=-1)
        h = modulate(rmsnorm(x, norm_mix_w[l]), shift_m, scale_m)
        proj = h @ w_in[l]
        qa, ka, va, qr, kr, vr, gr = jnp.split(proj, splits, axis=-1)
        attn = moba_attention(split_heads(qa, N_ATTN_HEADS, ATTN_HEAD_DIM),
                              split_heads(ka, N_ATTN_HEADS, ATTN_HEAD_DIM),
                              split_heads(va, N_ATTN_HEADS, ATTN_HEAD_DIM))
        ret = multiscale_retention(split_heads(qr, RET_HEADS, RET_HEAD_DIM),
                                   split_heads(kr, RET_HEADS, RET_HEAD_DIM),
                                   split_heads(vr, RET_HEADS, RET_HEAD_DIM))
        rf = ret.astype(F32)
        rf = rf * lax.rsqrt(jnp.mean(rf * rf, axis=-1, keepdims=True) + NORM_EPS)
        ret_out = merge_heads(rf.astype(x.dtype)) * ret_norm_w[l] * jax.nn.silu(gr)
        mix = jnp.concatenate([merge_heads(attn), ret_out.astype(x.dtype)], axis=-1) @ w_out[l]
        x = x + gate_m[:, None, :] * mix
        h2 = modulate(rmsnorm(x, norm_ffn_w[l]), shift_f, scale_f)
        x = x + gate_f[:, None, :] * hier_moe(h2, w_group[l], b_group[l], w_router[l], b_router[l],
                                             w1[l], w3[l], w2[l])
    return rmsnorm(x, norm_final_w)
```

```cpp
#include <hip/hip_runtime.h>
#include <hip/hip_bf16.h>
#include <cstdio>
#include <cstdint>

constexpr int DM = 2048, NB = 4, SEQ = 4096, MTOK = NB * SEQ;
constexpr int AH = 8, AD = 128, AW = 1024;
constexpr int RH = 4, RD = 256, RW = 1024;
constexpr int INW = 7168;
constexpr int NE = 32, DE = 512;
constexpr int NMOD = 6 * DM;
constexpr int C_QA = 0, C_KA = 1024, C_VA = 2048, C_QR = 3072, C_KR = 4096, C_VR = 5120, C_GR = 6144;
constexpr float EPS = 1e-6f;
constexpr int LCAP = 16384;

typedef unsigned short bf16_t;
#define LAS __attribute__((address_space(3)))
#define GAS __attribute__((address_space(1)))
typedef short bf16x8 __attribute__((ext_vector_type(8)));
typedef float f32x4 __attribute__((ext_vector_type(4)));
typedef unsigned u32x4 __attribute__((ext_vector_type(4)));
typedef unsigned u32x2 __attribute__((ext_vector_type(2)));

__device__ __forceinline__ float bf2f(bf16_t v) { return __uint_as_float((unsigned)v << 16); }
__device__ __forceinline__ unsigned f2bf(float f) { unsigned u = __float_as_uint(f); return (u + 0x7fffu + ((u >> 16) & 1u)) >> 16; }
__device__ __forceinline__ unsigned pk2(float lo, float hi) { return f2bf(lo) | (f2bf(hi) << 16); }
__device__ __forceinline__ float ldf(const float* p) { return *p; }
__device__ __forceinline__ float ldf(const bf16_t* p) { return bf2f(*p); }
__device__ __forceinline__ void stf(float* p, float v) { *p = v; }
__device__ __forceinline__ void stf(bf16_t* p, float v) { *p = (bf16_t)f2bf(v); }
__device__ __forceinline__ float silu_f(float v) { return v / (1.f + __expf(-v)); }
__device__ __forceinline__ unsigned cvt4_fp8(float a, float b, float c, float d) { int w = __builtin_amdgcn_cvt_pk_fp8_f32(a, b, 0, false); w = __builtin_amdgcn_cvt_pk_fp8_f32(c, d, w, true); return (unsigned)w; }
typedef int i32x8 __attribute__((ext_vector_type(8)));
typedef int i32x4 __attribute__((ext_vector_type(4)));
constexpr float W13_SCALE = 64.f, W2_SCALE = 32.f;

constexpr size_t MiB = 1u << 20;
constexpr size_t WS_CTL = 0, CTL_ZERO_BYTES = 1 * MiB;
constexpr size_t CTL_BAR = 0;
constexpr size_t CTL_CNT = 256 * 1024;
constexpr size_t CTL_KMEAN = 512 * 1024;
constexpr size_t WS_MODP = 1 * MiB;
constexpr size_t WS_MOD = 4 * MiB;
constexpr size_t WS_ELIST = 5 * MiB;
constexpr size_t WS_ELISTW = 7 * MiB;
constexpr size_t WS_TOKSLOT = 9 * MiB;
constexpr size_t WS_EID = 9 * MiB + 256 * 1024;
constexpr size_t WS_EWT = 9 * MiB + 512 * 1024;
constexpr size_t WS_WR = 10 * MiB;
constexpr size_t WS_WIN = 12 * MiB;
constexpr size_t WS_WOUT = 40 * MiB;
constexpr size_t WS_W13 = 48 * MiB;
constexpr size_t WS_W2 = 176 * MiB;
constexpr size_t WS_H = 240 * MiB;
constexpr size_t WS_ATT = 304 * MiB;
constexpr size_t WS_PROJ = 368 * MiB;
constexpr size_t WS_X1 = WS_PROJ + 128 * MiB;
constexpr size_t WS_END = 592 * MiB;

#ifndef PROBE_PHASE
#define PROBE_PHASE -1
#endif
#ifndef PROBE_STOP
#define PROBE_STOP 0
#endif
#ifndef PROBE_REPS
#define PROBE_REPS 1
#endif
constexpr int NWAVES = 8, NTHR = 512;
constexpr int RING_OFF = 0, RING_BYTES = 131072;
constexpr int LDSCTL_OFF = RING_BYTES, MISC_OFF = LDSCTL_OFF + 320;
constexpr int LDS_BYTES = 147456;

typedef GAS unsigned gu32;
#define RLX_AGENT __ATOMIC_RELAXED, __HIP_MEMORY_SCOPE_AGENT
#define LDS_WAIT() asm volatile("s_waitcnt lgkmcnt(0)" ::: "memory")
#define VM_WAIT() asm volatile("s_waitcnt vmcnt(0)" ::: "memory")

#define XB_TMO      128
#define XB_XCNT(j)  (256  + 64 * (j))
#define XB_XSUB(j)  (1280 + 64 * (j))
#define XB_XGEN(j)  (2304 + 64 * (j))
#define XB_TOP      3328
#define XB_TOPGEN   3392
#define XCD_BAR_WORDS 3456
#define XB_SPIN_CAP (1u << 18)
__device__ __forceinline__ unsigned xb_ld(unsigned* p)              { return __hip_atomic_load(p, __ATOMIC_RELAXED, __HIP_MEMORY_SCOPE_AGENT); }
__device__ __forceinline__ unsigned xb_add(unsigned* p, unsigned v) { return __hip_atomic_fetch_add(p, v, __ATOMIC_RELAXED, __HIP_MEMORY_SCOPE_AGENT); }
__device__ __forceinline__ unsigned xb_xcc_id() { return (unsigned)__builtin_amdgcn_s_getreg((3 << 11) | 20) & 0xFu; }
#define XB_SPIN(cond, bar) do { unsigned _sp = 0; while (cond) { __builtin_amdgcn_s_sleep(1); \
    if ((++_sp & 255u) == 0u) { if (xb_ld(&(bar)[XB_TMO])) break; if (_sp > XB_SPIN_CAP) { atomicAdd(&(bar)[XB_TMO], 1u); break; } } } } while (0)
struct XcdBarrier { unsigned* bar; unsigned x; volatile LAS unsigned* st; };
__device__ __forceinline__ XcdBarrier xcd_barrier_post(unsigned* bar, volatile LAS unsigned* st) {
    XcdBarrier b; b.bar = bar; b.x = xb_xcc_id(); b.st = st;
    if (threadIdx.x == 0) (void)xb_add(&bar[XB_XCNT(b.x)], 1u);
    return b;
}
__device__ __forceinline__ void xcd_barrier_complete(unsigned* bar, unsigned x, unsigned& nloc, unsigned& nx) {
    const unsigned G = gridDim.x * gridDim.y * gridDim.z;
    unsigned sum, cnt, mine, sp = 0u;
    for (;;) {
        sum = 0u; cnt = 0u; mine = 0u;
#pragma unroll
        for (unsigned j = 0; j < 16; ++j) { const unsigned c = xb_ld(&bar[XB_XCNT(j)]); sum += c; cnt += (c > 0u) ? 1u : 0u; mine = (j == x) ? c : mine; }
        if (sum == G) break;
        __builtin_amdgcn_s_sleep(1);
        if ((++sp & 255u) == 0u) { if (xb_ld(&bar[XB_TMO])) break; if (sp > XB_SPIN_CAP) { atomicAdd(&bar[XB_TMO], 1u); break; } }
    }
    nloc = mine > 0u ? mine : 1u; nx = cnt > 0u ? cnt : 1u;
}
__device__ __forceinline__ void xcd_barrier(const XcdBarrier& b) {
    asm volatile("s_waitcnt vmcnt(0)" ::: "memory");
    __syncthreads();
    if (threadIdx.x == 0) {
        unsigned* bar = b.bar;
        __builtin_amdgcn_s_waitcnt(0);
        unsigned nloc = b.st[0], nx = b.st[1];
        if (nloc == 0u) { xcd_barrier_complete(bar, b.x, nloc, nx); b.st[0] = nloc; b.st[1] = nx; }
        const unsigned old = xb_add(&bar[XB_XSUB(b.x)], 1u);
        const unsigned gen = old / nloc;
        if (old + 1u == (gen + 1u) * nloc) {
            __builtin_amdgcn_fence(__ATOMIC_RELEASE, "agent");
            asm volatile("s_waitcnt vmcnt(0)" ::: "memory");
            const unsigned og = xb_add(&bar[XB_TOP], 1u);
            const unsigned tg = og / nx;
            if (og + 1u == (tg + 1u) * nx) xb_add(&bar[XB_TOPGEN], 1u);
            else XB_SPIN(xb_ld(&bar[XB_TOPGEN]) == tg, bar);
            __builtin_amdgcn_fence(__ATOMIC_ACQUIRE, "agent");
            xb_add(&bar[XB_XGEN(b.x)], 1u);
            asm volatile("s_waitcnt vmcnt(0)" ::: "memory");
        } else {
            XB_SPIN(xb_ld(&bar[XB_XGEN(b.x)]) == gen, bar);
            __builtin_amdgcn_fence(__ATOMIC_ACQUIRE, "agent");
            asm volatile("s_waitcnt vmcnt(0)" ::: "memory");
        }
    }
    __syncthreads();
}

namespace pg8 {
constexpr int BM = 256, BK = 64, HALF = 128, HTB = HALF * BK * 2, STAGE_BYTES = 8 * HTB, NXCD = 8, WGM = 2;
__host__ __device__ __forceinline__ int lds_byte(int r, int c) { const int st = (r >> 4) * 2 + (c >> 5), rr = r & 15, cc = c & 31, ob = rr * 64 + cc * 2; return st * 1024 + (ob ^ (((ob >> 9) & 1) << 5)); }
__host__ __device__ __forceinline__ void stage_rc(int b, int& R, int& C) { const int st = b / 1024, sb = b % 1024, swz = sb ^ (((sb >> 9) & 1) << 5); R = (st >> 1) * 16 + swz / 64; C = (st & 1) * 32 + (swz % 64) / 2; }
__host__ __device__ __forceinline__ int perm32(int rho) { const int n = rho >> 4, i = rho & 15; return 8 * (i >> 2) + 4 * n + (i & 3); }
struct Unit { int pm, pn, e, nrows, row0; };
typedef __bf16 bf16x2n __attribute__((ext_vector_type(2)));
typedef float f32x2n __attribute__((ext_vector_type(2)));
__device__ __forceinline__ unsigned cvt_pk_bf16(float lo, float hi) { const f32x2n v = {lo, hi}; return __builtin_bit_cast(unsigned, __builtin_convertvector(v, bf16x2n)); }

struct DenseOrder {
    int nM, nN, nwg, G, c, K;
    __device__ void init(int M, int N, int K_, int G_, int c_) { nM = M / BM; nN = N / BM; nwg = nM * nN; G = G_; c = c_; K = K_; }
    __device__ __forceinline__ bool next(int i, Unit& u) const {
        const long L = (long)i * G + c; if (L >= nwg) return false;
        int wgid = (int)L;
        const int nig = WGM * nN, gid = wgid / nig, fm = gid * WGM, gsz = (nM - fm) < WGM ? (nM - fm) : WGM;
        u.pm = fm + ((wgid % nig) % gsz); u.pn = (wgid % nig) / gsz; u.e = 0; u.nrows = BM; u.row0 = u.pm * BM; return true;
    }
    __device__ __forceinline__ unsigned a_rowoff(const Unit& u, int r) const { return (unsigned)(u.pm * BM + r) * (unsigned)(K * 2); }
    __device__ __forceinline__ size_t b_off(const Unit& u) const { return (size_t)u.pn * BM * K * 2; }
};

template <class Epi, class Sched, bool FP8 = false>
__device__ __forceinline__ void gemm_phase(LAS unsigned char* lds, const void* Aptr, const void* Btptr, const int KB  , const Sched& S, const Epi& E) {
    const int tid = threadIdx.x, wid = __builtin_amdgcn_readfirstlane(tid >> 6), lane = tid & 63, wr = wid >> 2, wc = wid & 3, fr = lane & 15, fq = lane >> 4;
    const int nt = KB / (BK * 2);
    int sR[2], sC[2]; unsigned voffB[2];
#pragma unroll
    for (int i = 0; i < 2; ++i) { stage_rc(tid * 16 + i * 8192, sR[i], sC[i]); const int Rb = Epi::PERM ? ((sR[i] & ~31) + perm32(sR[i] & 31)) : sR[i]; voffB[i] = (unsigned)(Rb * KB + sC[i] * 2); }
    const size_t kstep = (size_t)(BK * 2);
    const size_t hstepB = (size_t)HALF * KB;
    const unsigned ldsw = (unsigned)wid * 1024u;
    const int aoff = lds_byte(wr * 64 + fr, fq * 8), boff = lds_byte(wc * 32 + fr, fq * 8);
    const char* Ab = (const char*)Aptr; const char* Bb = (const char*)Btptr;
#define PG8_SA(b, h) (((b) * 2 + (h)) * HTB)
#define PG8_SB(b, h) ((4 + (b) * 2 + (h)) * HTB)
#define PG8_STAGE_B(bufoff, gbase) do { _Pragma("unroll") for (int _i = 0; _i < 2; ++_i) \
        __builtin_amdgcn_global_load_lds((const unsigned*)((const char*)(gbase) + voffB[_i]), (LAS unsigned*)(lds + (bufoff) + ldsw + _i * 8192), 16, 0, 0); } while (0)
#define PG8_STAGE_A(bufoff, vo, h, kb) do { _Pragma("unroll") for (int _i = 0; _i < 2; ++_i) \
        __builtin_amdgcn_global_load_lds((const unsigned*)(Ab + (size_t)(vo)[h][_i] + (kb)), (LAS unsigned*)(lds + (bufoff) + ldsw + _i * 8192), 16, 0, 0); } while (0)
#define PG8_LD8(p) __builtin_shufflevector(*(const LAS i32x4*)(p), *(const LAS i32x4*)((p) + 1024), 0, 1, 2, 3, 4, 5, 6, 7)
#define PG8_LDA(dst, b, h) do { _Pragma("unroll") for (int m = 0; m < 4; ++m) { if constexpr (FP8) dst##8[m] = PG8_LD8(lds + PG8_SA(b, h) + aoff + m * 2048); \
        else { _Pragma("unroll") for (int k = 0; k < 2; ++k) dst[m][k] = *(const LAS bf16x8*)(lds + PG8_SA(b, h) + aoff + m * 2048 + k * 1024); } } } while (0)
#define PG8_LDB(dst, b, h) do { _Pragma("unroll") for (int n = 0; n < 2; ++n) { if constexpr (FP8) dst##8[n] = PG8_LD8(lds + PG8_SB(b, h) + boff + n * 2048); \
        else { _Pragma("unroll") for (int k = 0; k < 2; ++k) dst[n][k] = *(const LAS bf16x8*)(lds + PG8_SB(b, h) + boff + n * 2048 + k * 1024); } } } while (0)
#define PG8_MMA(ai, bj, At, Bt) do { __builtin_amdgcn_s_setprio(1); _Pragma("unroll") for (int m = 0; m < 4; ++m) _Pragma("unroll") for (int n = 0; n < 2; ++n) { \
        if constexpr (FP8) asm volatile("s_nop 1\n\tv_mfma_f32_16x16x128_f8f6f4 %0, %1, %2, %0" : "+v"(acc[ai][bj][m][n]) : "v"(Bt##8[n]), "v"(At##8[m])); \
        else { _Pragma("unroll") for (int k = 0; k < 2; ++k) acc[ai][bj][m][n] = __builtin_amdgcn_mfma_f32_16x16x32_bf16(Bt[n][k], At[m][k], acc[ai][bj][m][n], 0, 0, 0); } } __builtin_amdgcn_s_setprio(0); } while (0)
#define PG8_WAIT_V(n) asm volatile("s_waitcnt vmcnt(" #n ")" ::: "memory")
#define PG8_WAIT_L(n) asm volatile("s_waitcnt lgkmcnt(" #n ")" ::: "memory")
#define PG8_BAR __builtin_amdgcn_s_barrier()
#define PG8_SCHED __builtin_amdgcn_sched_barrier(0)
#define PG8_SETA(v, u) do { _Pragma("unroll") for (int _h = 0; _h < 2; ++_h) _Pragma("unroll") for (int _i = 0; _i < 2; ++_i) (v)[_h][_i] = S.a_rowoff((u), _h * HALF + sR[_i]) + (unsigned)(sC[_i] * 2); } while (0)
    Unit cur, nxt; int ui = 0;
    if (!S.next(0, cur)) return;
    f32x4 acc[2][2][4][2];
#pragma unroll
    for (int a = 0; a < 2; ++a)
#pragma unroll
        for (int b = 0; b < 2; ++b)
#pragma unroll
            for (int m = 0; m < 4; ++m)
#pragma unroll
                for (int n = 0; n < 2; ++n) acc[a][b][m][n] = (f32x4){0.f, 0.f, 0.f, 0.f};
    bf16x8 At[4][2], B0[2][2], B1[2][2]; i32x8 At8[4], B08[2], B18[2];
    unsigned cvA[2][2], nvA[2][2];
    PG8_SETA(cvA, cur);
    const char* cB = Bb + S.b_off(cur);
    PG8_STAGE_B(PG8_SB(0, 0), cB); PG8_STAGE_B(PG8_SB(0, 1), cB + hstepB); PG8_STAGE_A(PG8_SA(0, 0), cvA, 0, 0); PG8_STAGE_A(PG8_SA(0, 1), cvA, 1, 0);
    if (wr == 1) PG8_BAR;
    PG8_WAIT_V(2); PG8_BAR;
    PG8_STAGE_B(PG8_SB(1, 0), cB + kstep); PG8_STAGE_A(PG8_SA(1, 0), cvA, 0, kstep); PG8_STAGE_B(PG8_SB(1, 1), cB + hstepB + kstep);
    PG8_WAIT_V(6); PG8_BAR;
    for (;;) {
        const bool has_next = S.next(ui + 1, nxt);
        const char* nB = cB;
        if (has_next) { PG8_SETA(nvA, nxt); nB = Bb + S.b_off(nxt); }
        else {
#pragma unroll
            for (int _h = 0; _h < 2; ++_h)
#pragma unroll
                for (int _i = 0; _i < 2; ++_i) nvA[_h][_i] = cvA[_h][_i];
        }
        for (int t = 0; t < nt; t += 2) {
            const bool last = (t == nt - 2);
            const size_t k1 = (size_t)(t + 1) * kstep;
            const size_t k2 = last ? (size_t)0 : (size_t)(t + 2) * kstep;
            const size_t k3 = k2 + kstep;
            unsigned xA[2][2];
#pragma unroll
            for (int _h = 0; _h < 2; ++_h)
#pragma unroll
                for (int _i = 0; _i < 2; ++_i) xA[_h][_i] = last ? nvA[_h][_i] : cvA[_h][_i];
            const char* b2 = (last ? nB : cB) + k2; const char* b3 = b2 + kstep;
            PG8_LDB(B0, 0, 0); PG8_LDB(B1, 0, 1); PG8_SCHED; PG8_LDA(At, 0, 0); PG8_STAGE_A(PG8_SA(1, 1), cvA, 1, k1);
            PG8_WAIT_V(8); PG8_WAIT_L(0); PG8_BAR; PG8_MMA(0, 0, At, B0); PG8_MMA(0, 1, At, B1); PG8_BAR; PG8_SCHED;
            PG8_LDA(At, 0, 1); PG8_STAGE_B(PG8_SB(0, 0), b2); PG8_STAGE_B(PG8_SB(0, 1), b2 + hstepB); PG8_STAGE_A(PG8_SA(0, 0), xA, 0, k2);
            PG8_WAIT_V(8); PG8_WAIT_L(0); PG8_BAR; PG8_MMA(1, 0, At, B0); PG8_MMA(1, 1, At, B1); PG8_BAR; PG8_SCHED;
            PG8_LDB(B0, 1, 0); PG8_LDB(B1, 1, 1); PG8_SCHED; PG8_LDA(At, 1, 0); PG8_STAGE_A(PG8_SA(0, 1), xA, 1, k2);
            PG8_WAIT_V(8); PG8_WAIT_L(0); PG8_BAR; PG8_MMA(0, 0, At, B0); PG8_MMA(0, 1, At, B1); PG8_BAR; PG8_SCHED;
            PG8_LDA(At, 1, 1); PG8_STAGE_B(PG8_SB(1, 0), b3); PG8_STAGE_B(PG8_SB(1, 1), b3 + hstepB); PG8_STAGE_A(PG8_SA(1, 0), xA, 0, k3);
            PG8_WAIT_V(8); PG8_WAIT_L(0); PG8_BAR; PG8_MMA(1, 0, At, B0); PG8_MMA(1, 1, At, B1); PG8_BAR; PG8_SCHED;
        }
        if constexpr (FP8) asm volatile("s_nop 15\n\ts_nop 15" ::: "memory");
        if (wr == 0) PG8_BAR;
        E(acc, cur, wr, wc, fr, fq);
        if (!has_next) break;
#pragma unroll
        for (int a = 0; a < 2; ++a)
#pragma unroll
            for (int b = 0; b < 2; ++b)
#pragma unroll
                for (int m = 0; m < 4; ++m)
#pragma unroll
                    for (int n = 0; n < 2; ++n) acc[a][b][m][n] = (f32x4){0.f, 0.f, 0.f, 0.f};
        cur = nxt; cB = nB; ++ui;
#pragma unroll
        for (int _h = 0; _h < 2; ++_h)
#pragma unroll
            for (int _i = 0; _i < 2; ++_i) cvA[_h][_i] = nvA[_h][_i];
        if (wr == 1) PG8_BAR;
    }
    PG8_WAIT_V(0);
    PG8_BAR;
#undef PG8_SA
#undef PG8_SB
#undef PG8_STAGE_A
#undef PG8_STAGE_B
#undef PG8_LDA
#undef PG8_LDB
#undef PG8_MMA
#undef PG8_LD8
#undef PG8_WAIT_V
#undef PG8_WAIT_L
#undef PG8_BAR
#undef PG8_SCHED
#undef PG8_SETA
}

struct EpiProj {
    static constexpr bool PERM = true;
    bf16_t* O; float* kmean; int* kn2;
    __device__ __forceinline__ void operator()(const f32x4 (&acc)[2][2][4][2], const Unit& u, int wr, int wc, int fr, int fq) const {
        const int row0 = u.pm * BM + wr * 64 + fr, col0 = u.pn * BM + wc * 32 + 8 * fq;
#pragma unroll
        for (int ai = 0; ai < 2; ++ai)
#pragma unroll
            for (int m = 0; m < 4; ++m) { bf16_t* rowp = O + (size_t)(row0 + ai * HALF + m * 16) * INW + col0;
#pragma unroll
                for (int bj = 0; bj < 2; ++bj) { const f32x4 v0 = acc[ai][bj][m][0], v1 = acc[ai][bj][m][1];
                    u32x4 w; w.x = cvt_pk_bf16(v0[0], v0[1]); w.y = cvt_pk_bf16(v0[2], v0[3]); w.z = cvt_pk_bf16(v1[0], v1[1]); w.w = cvt_pk_bf16(v1[2], v1[3]);
                    *(u32x4*)(rowp + bj * HALF) = w; } }
        if (kmean && u.pn >= 4 && u.pn < 8) {
            const int b = u.pm >> 4, blk = u.pm & 15;
#pragma unroll
            for (int bj = 0; bj < 2; ++bj)
#pragma unroll
                for (int n = 0; n < 2; ++n) {
                    f32x4 s = (f32x4){0.f, 0.f, 0.f, 0.f};
#pragma unroll
                    for (int ai = 0; ai < 2; ++ai)
#pragma unroll
                        for (int m = 0; m < 4; ++m) s += acc[ai][bj][m][n];
#pragma unroll
                    for (int j = 0; j < 4; ++j) { float v = s[j]; v += __shfl_xor(v, 1); v += __shfl_xor(v, 2); v += __shfl_xor(v, 4); v += __shfl_xor(v, 8);
                        if (fr == 0) { const int col = (u.pn - 4) * BM + bj * HALF + wc * 32 + 8 * fq + 4 * n + j; const int h = col >> 7, d = col & 127;
                            atomicAdd(kmean + ((b * AH + h) * 16 + blk) * AD + d, v * (1.f / 256.f)); } }
                }
#pragma unroll
            for (int bj = 0; bj < 2; ++bj) { float mx = 0.f;
#pragma unroll
                for (int ai = 0; ai < 2; ++ai)
#pragma unroll
                    for (int m = 0; m < 4; ++m) { const f32x4 a0 = acc[ai][bj][m][0], a1 = acc[ai][bj][m][1];
                        float q = ((a0[0] * a0[0] + a0[1] * a0[1]) + (a0[2] * a0[2] + a0[3] * a0[3])) + ((a1[0] * a1[0] + a1[1] * a1[1]) + (a1[2] * a1[2] + a1[3] * a1[3]));
                        q += __shfl_xor(q, 16); q += __shfl_xor(q, 32); mx = fmaxf(mx, q); }
                mx = fmaxf(mx, __shfl_xor(mx, 1)); mx = fmaxf(mx, __shfl_xor(mx, 2)); mx = fmaxf(mx, __shfl_xor(mx, 4)); mx = fmaxf(mx, __shfl_xor(mx, 8));
                if (fr == 0 && fq == 0) atomicMax(kn2 + ((b * AH + (u.pn - 4) * 2 + bj) * 16 + blk) * 4 + wc, __float_as_int(mx)); }
        }
    }
};

struct EpiOut {
    static constexpr bool PERM = true;
    const float* x; const float* mod; bf16_t* out; float* rowss;
    __device__ __forceinline__ void operator()(const f32x4 (&acc)[2][2][4][2], const Unit& u, int wr, int wc, int fr, int fq) const {
        const int row0 = u.pm * BM + wr * 64 + fr, col0 = u.pn * BM + wc * 32 + 8 * fq, b = u.pm >> 4;
        f32x4 g[2][2];
#pragma unroll
        for (int bj = 0; bj < 2; ++bj)
#pragma unroll
            for (int n = 0; n < 2; ++n) g[bj][n] = *(const f32x4*)(mod + (size_t)b * NMOD + 2 * DM + col0 + bj * HALF + n * 4);
#pragma unroll
        for (int ai = 0; ai < 2; ++ai)
#pragma unroll
            for (int m = 0; m < 4; ++m) { const size_t off = (size_t)(row0 + ai * HALF + m * 16) * DM + col0; float ss = 0.f;
#pragma unroll
                for (int bj = 0; bj < 2; ++bj) { const f32x4 x0 = *(const f32x4*)(x + off + bj * HALF), x1v = *(const f32x4*)(x + off + bj * HALF + 4);
                    const f32x4 v0 = x0 + g[bj][0] * acc[ai][bj][m][0], v1 = x1v + g[bj][1] * acc[ai][bj][m][1];
                    ss += ((v0[0] * v0[0] + v0[1] * v0[1]) + (v0[2] * v0[2] + v0[3] * v0[3])) + ((v1[0] * v1[0] + v1[1] * v1[1]) + (v1[2] * v1[2] + v1[3] * v1[3]));
                    u32x4 w; w.x = cvt_pk_bf16(v0[0], v0[1]); w.y = cvt_pk_bf16(v0[2], v0[3]); w.z = cvt_pk_bf16(v1[0], v1[1]); w.w = cvt_pk_bf16(v1[2], v1[3]);
                    *(u32x4*)(out + off + bj * HALF) = w; }
                ss += __shfl_xor(ss, 16); ss += __shfl_xor(ss, 32);
                if (fq == 0) rowss[(size_t)(row0 + ai * HALF + m * 16) * 32 + u.pn * 4 + wc] = ss; }
    }
};

struct MoeOrder {
    const LAS int* tabs; const int* cnt; const int* elist; int npn, K, G, c, gather; size_t bstride;
    __device__ __forceinline__ bool next(int i, Unit& u) const {
        const int L = i * G + c, RT = __builtin_amdgcn_readfirstlane(tabs[33 + 32]);
        if (L >= RT * npn) return false;
        const int rt = L / npn; u.pn = L - rt * npn;
        int e = 0;
        for (int j = 1; j < NE; ++j) if (tabs[33 + j] <= rt) e = j;
        e = __builtin_amdgcn_readfirstlane(e);
        u.e = e; u.pm = __builtin_amdgcn_readfirstlane(rt - tabs[33 + e]); u.pn = __builtin_amdgcn_readfirstlane(u.pn);
        const int ce = __builtin_amdgcn_readfirstlane(tabs[e + 1] - tabs[e]);
        u.nrows = min(BM, ce - u.pm * BM); u.row0 = __builtin_amdgcn_readfirstlane(tabs[e]) + u.pm * BM; return true;
    }
    __device__ __forceinline__ unsigned a_rowoff(const Unit& u, int r) const {
        if (gather) { const int idx = (r < u.nrows) ? u.pm * BM + r : u.pm * BM; return (unsigned)(elist[u.e * LCAP + idx] >> 1) * (unsigned)K; }
        const int row = min(u.row0 + r, 2 * MTOK - 1); return (unsigned)row * (unsigned)K;
    }
    __device__ __forceinline__ size_t b_off(const Unit& u) const { return (size_t)u.e * bstride + (size_t)u.pn * BM * K; }
};
__device__ __forceinline__ float silu_fast(float v) { return v * __builtin_amdgcn_rcpf(1.f + __expf(-v)); }
struct EpiAct {
    static constexpr bool PERM = true;
    unsigned char* O;
    __device__ __forceinline__ void operator()(const f32x4 (&acc)[2][2][4][2], const Unit& u, int wr, int wc, int fr, int fq) const {
        const int col0 = u.pn * HALF + wc * 32 + 8 * fq; constexpr float IS = 1.f / W13_SCALE;
#pragma unroll
        for (int ai = 0; ai < 2; ++ai)
#pragma unroll
            for (int m = 0; m < 4; ++m) { const int rl = ai * HALF + wr * 64 + m * 16 + fr;
                if (rl < u.nrows) { const f32x4 a0 = acc[ai][0][m][0] * IS, a1 = acc[ai][0][m][1] * IS, b0 = acc[ai][1][m][0] * IS, b1 = acc[ai][1][m][1] * IS;
                    u32x2 w; w.x = cvt4_fp8(silu_fast(a0[0]) * b0[0], silu_fast(a0[1]) * b0[1], silu_fast(a0[2]) * b0[2], silu_fast(a0[3]) * b0[3]);
                    w.y = cvt4_fp8(silu_fast(a1[0]) * b1[0], silu_fast(a1[1]) * b1[1], silu_fast(a1[2]) * b1[2], silu_fast(a1[3]) * b1[3]);
                    *(u32x2*)(O + (size_t)(u.row0 + rl) * DE + col0) = w; } }
    }
};
struct EpiY {
    static constexpr bool PERM = true;
    unsigned char* O; const float* elistw;
    __device__ __forceinline__ void operator()(const f32x4 (&acc)[2][2][4][2], const Unit& u, int wr, int wc, int fr, int fq) const {
        const int col0 = u.pn * BM + wc * 32 + 8 * fq;
#pragma unroll
        for (int ai = 0; ai < 2; ++ai)
#pragma unroll
            for (int m = 0; m < 4; ++m) { const int rl = ai * HALF + wr * 64 + m * 16 + fr;
                if (rl < u.nrows) { const float rw = elistw[u.e * LCAP + u.pm * BM + rl] * (1.f / W2_SCALE); unsigned char* rowp = O + (size_t)(u.row0 + rl) * DM + col0;
#pragma unroll
                    for (int bj = 0; bj < 2; ++bj) { const f32x4 v0 = acc[ai][bj][m][0] * rw, v1 = acc[ai][bj][m][1] * rw;
                        u32x2 w; w.x = cvt4_fp8(v0[0], v0[1], v0[2], v0[3]); w.y = cvt4_fp8(v1[0], v1[1], v1[2], v1[3]);
                        *(u32x2*)(rowp + bj * HALF) = w; } } }
    }
};
}


#ifndef MB_SDEPTH
#define MB_SDEPTH 2
#endif
namespace mb {
using s16x4  = __attribute__((ext_vector_type(4))) short;
using f32x16 = __attribute__((ext_vector_type(16))) float;
constexpr int D = 128, NW = 8, QBLK = 32, KVBLK = 64;
constexpr float SCALE = 0.088388347648318440f;
constexpr float THR = 8.f;
constexpr size_t SHM_V = KVBLK * D * 2, SHM_K = KVBLK * D * 2;
constexpr size_t OFF_WS = 2 * SHM_V + 2 * SHM_K, OFF_KM = OFF_WS + NW * 64 * 4;
constexpr size_t LDS_NEED = OFF_KM + 16 * 128 * 4 + 128;
constexpr float NEG = -1e30f;
#define KSWZ(row, colB) ((row) * 256 + ((colB) ^ (((row) & 7) << 4)))
#define SBAR() __builtin_amdgcn_sched_barrier(0)
__device__ __forceinline__ int crow(int r, int hi) { return (r & 3) + 8 * (r >> 2) + 4 * hi; }
__device__ __forceinline__ unsigned cvtpk(float lo, float hi) { return pg8::cvt_pk_bf16(lo, hi); }
__device__ __forceinline__ void partialSM(f32x16& p0, f32x16& p1, float& m_reg, float& mn, float& alpha) {
  constexpr float C = SCALE * 1.4426950408889634f;
  float pmax = p0[0];
#pragma unroll
  for (int r = 1; r < 16; ++r) pmax = fmaxf(pmax, p0[r]);
#pragma unroll
  for (int r = 0; r < 16; ++r) pmax = fmaxf(pmax, p1[r]);
  { auto rr = __builtin_amdgcn_permlane32_swap(__float_as_uint(pmax), __float_as_uint(pmax), false, false);
    pmax = fmaxf(__uint_as_float(rr[0]), __uint_as_float(rr[1])); }
  if (__builtin_expect(__all(pmax - m_reg <= THR / SCALE), 1)) { mn = m_reg; alpha = 1.f; }
  else { mn = fmaxf(m_reg, pmax); alpha = __builtin_amdgcn_exp2f((m_reg - mn) * C); m_reg = mn; }
  float mnC = -mn * C;
#pragma unroll
  for (int r = 0; r < 16; ++r) p0[r] = fmaf(p0[r], C, mnC);
#pragma unroll
  for (int r = 0; r < 16; ++r) p1[r] = fmaf(p1[r], C, mnC);
#pragma unroll
  for (int r = 0; r < 16; ++r) p0[r] = __builtin_amdgcn_exp2f(p0[r]);
}
__device__ __forceinline__ void finishSM(f32x16& p0, f32x16& p1, float alpha, float& l_reg, bf16x8& pa0, bf16x8& pa1, bf16x8& pa2, bf16x8& pa3) {
#pragma unroll
  for (int r = 0; r < 16; ++r) p1[r] = __builtin_amdgcn_exp2f(p1[r]);
  float ps = 0;
#pragma unroll
  for (int r = 0; r < 16; ++r) ps += p0[r];
#pragma unroll
  for (int r = 0; r < 16; ++r) ps += p1[r];
  { auto rr = __builtin_amdgcn_permlane32_swap(__float_as_uint(ps), __float_as_uint(ps), false, false);
    ps = __uint_as_float(rr[0]) + __uint_as_float(rr[1]); }
  l_reg = l_reg * alpha + ps;
#define PK4(P, BASE, OUT) do { unsigned a0 = cvtpk(P[BASE + 0], P[BASE + 1]), a1 = cvtpk(P[BASE + 2], P[BASE + 3]);   \
    unsigned b0 = cvtpk(P[BASE + 4], P[BASE + 5]), b1 = cvtpk(P[BASE + 6], P[BASE + 7]);                              \
    auto r0 = __builtin_amdgcn_permlane32_swap(a0, b0, false, false); auto r1 = __builtin_amdgcn_permlane32_swap(a1, b1, false, false); \
    u32x4 w = {r0[0], r1[0], r0[1], r1[1]}; OUT = *reinterpret_cast<bf16x8*>(&w); } while (0)
  PK4(p0, 0, pa0); PK4(p0, 8, pa1); PK4(p1, 0, pa2); PK4(p1, 8, pa3);
#undef PK4
}
__device__ __forceinline__ void qkt(f32x16& p0, f32x16& p1, const bf16_t* Ks, const bf16x8* qr, int r32, int hi) {
#pragma unroll
  for (int d0 = 0; d0 < 8; ++d0) { int cb = (d0 * 16 + hi * 8) * 2;
    bf16x8 b0 = *reinterpret_cast<const bf16x8*>((const char*)Ks + KSWZ(r32, cb));
    bf16x8 b1 = *reinterpret_cast<const bf16x8*>((const char*)Ks + KSWZ(32 + r32, cb));
    p0 = __builtin_amdgcn_mfma_f32_32x32x16_bf16(b0, qr[d0], p0, 0, 0, 0);
    p1 = __builtin_amdgcn_mfma_f32_32x32x16_bf16(b1, qr[d0], p1, 0, 0, 0); }
}
__device__ __forceinline__ int v_st(int k, int c) { const int kk = (k & ~0xC) | ((k & 4) << 1) | ((k & 8) >> 1); return ((kk >> 3) * 4 + (c >> 5)) * 512 + ((kk & 7) * 32 + (c & 31)) * 2; }
__device__ __forceinline__ int v_rd_base(int lane) { return ((lane & 3) << 3) | (((lane >> 2) & 3) << 6) | (((lane >> 4) & 1) << 5) | (((lane >> 5) & 1) << 8); }
constexpr int v_rd_off(int d0, int ks, int half) { return d0 * 512 + ks * 4096 + half * 2048; }
template <int OFF> __device__ __forceinline__ s16x4 tr_read(int vb) {
  s16x4 r; asm volatile("ds_read_b64_tr_b16 %0, %1 offset:%2" : "=&v"(r) : "v"(vb), "i"(OFF) : "memory"); return r;
}
template <int D0> __device__ __forceinline__ void pv_one(f32x16& od, int vb, bf16x8 pa0, bf16x8 pa1, bf16x8 pa2, bf16x8 pa3) {
  const s16x4 l0 = tr_read<v_rd_off(D0, 0, 0)>(vb), h0 = tr_read<v_rd_off(D0, 0, 1)>(vb), l1 = tr_read<v_rd_off(D0, 1, 0)>(vb), h1 = tr_read<v_rd_off(D0, 1, 1)>(vb);
  const s16x4 l2 = tr_read<v_rd_off(D0, 2, 0)>(vb), h2 = tr_read<v_rd_off(D0, 2, 1)>(vb), l3 = tr_read<v_rd_off(D0, 3, 0)>(vb), h3 = tr_read<v_rd_off(D0, 3, 1)>(vb);
  asm volatile("s_waitcnt lgkmcnt(0)" ::: "memory"); SBAR();
#define PK(L, H) (bf16x8){L[0], L[1], L[2], L[3], H[0], H[1], H[2], H[3]}
  od = __builtin_amdgcn_mfma_f32_32x32x16_bf16(pa0, PK(l0, h0), od, 0, 0, 0);
  od = __builtin_amdgcn_mfma_f32_32x32x16_bf16(pa1, PK(l1, h1), od, 0, 0, 0);
  od = __builtin_amdgcn_mfma_f32_32x32x16_bf16(pa2, PK(l2, h2), od, 0, 0, 0);
  od = __builtin_amdgcn_mfma_f32_32x32x16_bf16(pa3, PK(l3, h3), od, 0, 0, 0);
#undef PK
}
__device__ __forceinline__ void pv_d0(f32x16* o, int vb, bf16x8 pa0, bf16x8 pa1, bf16x8 pa2, bf16x8 pa3) {
  pv_one<0>(o[0], vb, pa0, pa1, pa2, pa3); pv_one<1>(o[1], vb, pa0, pa1, pa2, pa3); pv_one<2>(o[2], vb, pa0, pa1, pa2, pa3); pv_one<3>(o[3], vb, pa0, pa1, pa2, pa3);
}
__device__ __forceinline__ int kst(int t, int I, int pm) { return t < 4 ? 256 * I + 64 * t : 64 * (pm + t - 4); }
__device__ __forceinline__ void mkinit(f32x16& c0, f32x16& c1, int t, int I, int qrel, int hi, unsigned selmask, float sl, int pm) {
  float slv = sl; asm volatile("" : "+v"(slv));
  if (t < 4) {
    const int kb = 64 * t + 4 * hi, lim = qrel - kb; const float b0 = slv * (float)kb, b1 = slv * (float)(kb + 32);
#pragma unroll
    for (int r = 0; r < 16; ++r) { const int c = (r & 3) + 8 * (r >> 2);
      c0[r] = (c <= lim) ? fmaf(slv, (float)c, b0) : NEG; c1[r] = (c + 32 <= lim) ? fmaf(slv, (float)c, b1) : NEG; }
  } else {
    const int jt = pm + t - 4, pb = jt >> 2; const bool ok = (selmask >> pb) & 1u;
    const int kb = 64 * jt - 256 * I + 4 * hi;
    const float b0 = ok ? slv * (float)kb : NEG, b1 = ok ? slv * (float)(kb + 32) : NEG;
#pragma unroll
    for (int r = 0; r < 16; ++r) { const int c = (r & 3) + 8 * (r >> 2); c0[r] = fmaf(slv, (float)c, b0); c1[r] = fmaf(slv, (float)c, b1); }
  }
}
__device__ __forceinline__ void moba_unit(int b, int h, int I, const bf16_t* __restrict__ PROJ, const float* __restrict__ kmean, const float* __restrict__ kn2, bf16_t* __restrict__ ATT, char* lds) {
  int tid_ = threadIdx.x; asm volatile("" : "+v"(tid_));
  const int tid = tid_, wid = tid >> 6, lane = tid & 63, r32 = lane & 31, hi = lane >> 5;
  bf16_t* V_lds = (bf16_t*)lds; bf16_t* K_lds = (bf16_t*)(lds + 2 * SHM_V);
  float* wsf = (float*)(lds + OFF_WS) + wid * 64; float* li_l = wsf; float* al_l = wsf + 32;
  float* km = (float*)(lds + OFF_KM);
  const bf16_t* Qb = PROJ + (size_t)(b * SEQ + 256 * I) * INW + C_QA + h * D;
  const bf16_t* Kh = PROJ + (size_t)(b * SEQ) * INW + C_KA + h * D;
  const bf16_t* Vh = PROJ + (size_t)(b * SEQ) * INW + C_VA + h * D;
  float m_reg = -1e30f, l_reg = 0; f32x16 o[4] = {}; bf16x8 qr[8];
  const bf16_t* Qw = Qb + (size_t)(wid * QBLK + r32) * INW + hi * 8;
#pragma unroll
  for (int d0 = 0; d0 < 8; ++d0) qr[d0] = *reinterpret_cast<const bf16x8*>(Qw + d0 * 16);
  const int sr = tid >> 4, sc = (tid & 15) * 8, vst0 = v_st(sr, sc), vst1 = v_st(32 + sr, sc);
  constexpr int SDEPTH = MB_SDEPTH;
  struct { bf16x8 vs0, vs1, ks0, ks1; } sr_[SDEPTH];
#define SLOAD(i, k0) do { sr_[i].vs0 = *(const bf16x8*)(&Vh[(size_t)((k0) + sr) * INW + sc]); sr_[i].vs1 = *(const bf16x8*)(&Vh[(size_t)((k0) + 32 + sr) * INW + sc]); \
    sr_[i].ks0 = *(const bf16x8*)(&Kh[(size_t)((k0) + sr) * INW + sc]); sr_[i].ks1 = *(const bf16x8*)(&Kh[(size_t)((k0) + 32 + sr) * INW + sc]); } while (0)
  SLOAD(0, 256 * I);
  { const float* kg = kmean + (size_t)((b * AH + h) * 16) * D;
    for (int i = tid; i < 16 * D / 4; i += 512) ((f32x4*)km)[i] = ((const f32x4*)kg)[i]; }
  float* bnd = (float*)(lds + OFF_KM + 16 * D * 4);
  { float qs = 0.f;
#pragma unroll
    for (int d0 = 0; d0 < 8; ++d0)
#pragma unroll
      for (int j = 0; j < 8; ++j) { const float qv = __uint_as_float((unsigned)(unsigned short)qr[d0][j] << 16); qs = fmaf(qv, qv, qs); }
    { auto rr = __builtin_amdgcn_permlane32_swap(__float_as_uint(qs), __float_as_uint(qs), false, false); qs = __uint_as_float(rr[0]) + __uint_as_float(rr[1]); }
    qs = fmaxf(qs, __shfl_xor(qs, 1)); qs = fmaxf(qs, __shfl_xor(qs, 2)); qs = fmaxf(qs, __shfl_xor(qs, 4)); qs = fmaxf(qs, __shfl_xor(qs, 8)); qs = fmaxf(qs, __shfl_xor(qs, 16));
    if (lane == 0) bnd[16 + wid] = qs;
    if (tid < 16) { const float* kp = kn2 + ((b * AH + h) * 16 + tid) * 4; bnd[tid] = (kp[0] + kp[1]) + (kp[2] + kp[3]); } }
  __syncthreads();
  int p_min = 0;
  { float qm = 0.f, kmx = 0.f;
#pragma unroll
    for (int w = 0; w < 8; ++w) qm = fmaxf(qm, bnd[16 + w]);
    for (int n = 0; n <= I; ++n) kmx = fmaxf(kmx, bnd[n]);
    const float Bnd = SCALE * sqrtf(qm * kmx) * 1.03f, slope = exp2f(-(float)(h + 1));
    for (int jt = 0; jt < 4 * I; ++jt) if (slope * (float)(256 * I - 64 * jt - 63) > 2.f * Bnd + THR + 104.f) p_min = jt + 1;
    p_min = __builtin_amdgcn_readfirstlane(p_min) & ~1; }
  unsigned selmask = 0u;
  { float v1 = -INFINITY, v2 = -INFINITY, v3 = -INFINITY; int i1 = -1, i2 = -1, i3 = -1;
#pragma unroll 1
    for (int n = 0; n < I; ++n) {
      const float* kn = km + n * D + hi * 8; float g = 0.f;
#pragma unroll
      for (int d0 = 0; d0 < 8; ++d0) { const f32x4 k0 = *(const f32x4*)(kn + d0 * 16), k1 = *(const f32x4*)(kn + d0 * 16 + 4);
        float qf[8];
#pragma unroll
        for (int j = 0; j < 8; ++j) qf[j] = __uint_as_float((unsigned)(unsigned short)qr[d0][j] << 16);
        g += (qf[0] * k0.x + qf[1] * k0.y) + (qf[2] * k0.z + qf[3] * k0.w) + (qf[4] * k1.x + qf[5] * k1.y) + (qf[6] * k1.z + qf[7] * k1.w); }
      { auto rr = __builtin_amdgcn_permlane32_swap(__float_as_uint(g), __float_as_uint(g), false, false); g = __uint_as_float(rr[0]) + __uint_as_float(rr[1]); }
      if (g > v1) { v3 = v2; i3 = i2; v2 = v1; i2 = i1; v1 = g; i1 = n; }
      else if (g > v2) { v3 = v2; i3 = i2; v2 = g; i2 = n; }
      else if (g > v3) { v3 = g; i3 = n; }
    }
    if (i1 >= 0) selmask |= 1u << i1; if (i2 >= 0) selmask |= 1u << i2; if (i3 >= 0) selmask |= 1u << i3;
  }
  const float sl = exp2f(-(float)(h + 1)) / SCALE;
  const int qrel = wid * QBLK + r32;
  const int vb0 = (int)(uintptr_t)V_lds + v_rd_base(lane);
#define SWRITE(bb, i) do { *(bf16x8*)((char*)V_lds + (bb) * SHM_V + vst0) = sr_[i].vs0;          \
    *(bf16x8*)((char*)V_lds + (bb) * SHM_V + vst1) = sr_[i].vs1; int kc = sc * 2;               \
    *(bf16x8*)((char*)K_lds + (bb) * SHM_K + KSWZ(sr, kc)) = sr_[i].ks0;                       \
    *(bf16x8*)((char*)K_lds + (bb) * SHM_K + KSWZ(32 + sr, kc)) = sr_[i].ks1; } while (0)
#define SWAIT() do { if constexpr (SDEPTH == 2) asm volatile("s_waitcnt vmcnt(4)" ::: "memory"); else asm volatile("s_waitcnt vmcnt(0)" ::: "memory"); } while (0)
#define RESC(a) do { if (__any((a) < 1.f)) { if (hi == 0) al_l[r32] = (a); asm volatile("s_waitcnt lgkmcnt(0)" ::: "memory"); \
    _Pragma("unroll") for (int d = 0; d < 4; ++d) _Pragma("unroll") for (int r = 0; r < 16; ++r) o[d][r] *= al_l[crow(r, hi)]; } } while (0)
  f32x16 pA0, pA1, pB0, pB1; float mnA, mnB, alA, alB; bf16x8 pa0, pa1, pa2, pa3; const int NT = 4 * (I + 1) - p_min;
  constexpr int SE = 0, SO = SDEPTH - 1;
  static_assert(SE == 0, "the early tile load above uses slot SE");
  if (__builtin_amdgcn_readfirstlane(tid) >= 256) __builtin_amdgcn_s_setprio(1);
  asm volatile("s_waitcnt vmcnt(0)" ::: "memory"); SWRITE(0, SE); __syncthreads();
  mkinit(pA0, pA1, 0, I, qrel, hi, selmask, sl, p_min); qkt(pA0, pA1, K_lds, qr, r32, hi); partialSM(pA0, pA1, m_reg, mnA, alA);
  SLOAD(SO, kst(1, I, p_min)); if constexpr (SDEPTH == 2) { if (2 < NT) SLOAD(SE, kst(2, I, p_min)); }
  SWAIT(); SWRITE(1, SO); __syncthreads();
  for (int j = 1; j + 1 < NT; j += 2) {
    SBAR(); mkinit(pB0, pB1, j, I, qrel, hi, selmask, sl, p_min); qkt(pB0, pB1, (bf16_t*)((char*)K_lds + SHM_K), qr, r32, hi);
    finishSM(pA0, pA1, alA, l_reg, pa0, pa1, pa2, pa3); SBAR();
    SLOAD(SO, kst(j + SDEPTH, I, p_min)); SBAR();
    pv_d0(o, vb0, pa0, pa1, pa2, pa3); partialSM(pB0, pB1, m_reg, mnB, alB);
    __syncthreads(); SWAIT(); SWRITE(0, SE);
    RESC(alB); __syncthreads();
    SBAR(); mkinit(pA0, pA1, j + 1, I, qrel, hi, selmask, sl, p_min); qkt(pA0, pA1, K_lds, qr, r32, hi);
    finishSM(pB0, pB1, alB, l_reg, pa0, pa1, pa2, pa3); SBAR();
    if (SDEPTH == 1 || j + 3 < NT) SLOAD(SE, kst(j + 1 + SDEPTH, I, p_min)); SBAR();
    pv_d0(o, vb0 + (int)SHM_V, pa0, pa1, pa2, pa3); partialSM(pA0, pA1, m_reg, mnA, alA);
    __syncthreads(); SWAIT(); SWRITE(1, SO);
    RESC(alA); __syncthreads();
  }
  SBAR(); mkinit(pB0, pB1, NT - 1, I, qrel, hi, selmask, sl, p_min); qkt(pB0, pB1, (bf16_t*)((char*)K_lds + SHM_K), qr, r32, hi);
  finishSM(pA0, pA1, alA, l_reg, pa0, pa1, pa2, pa3); SBAR();
  pv_d0(o, vb0, pa0, pa1, pa2, pa3); partialSM(pB0, pB1, m_reg, mnB, alB);
  __syncthreads(); RESC(alB);
  finishSM(pB0, pB1, alB, l_reg, pa0, pa1, pa2, pa3); SBAR();
  pv_d0(o, vb0 + (int)SHM_V, pa0, pa1, pa2, pa3);
  __builtin_amdgcn_s_setprio(0);
  if (hi == 0) li_l[r32] = l_reg; asm volatile("s_waitcnt lgkmcnt(0)" ::: "memory");
  float rli[16];
#pragma unroll
  for (int r = 0; r < 16; ++r) rli[r] = __builtin_amdgcn_rcpf(li_l[crow(r, hi)]);
  __syncthreads();
  bf16_t* stg = (bf16_t*)(lds + wid * 8192);
#pragma unroll
  for (int r = 0; r < 16; ++r) { const int orow = crow(r, hi);
#pragma unroll
    for (int d0 = 0; d0 < 4; ++d0) stg[orow * 128 + d0 * 32 + r32] = (bf16_t)f2bf(o[d0][r] * rli[r]); }
  asm volatile("s_waitcnt lgkmcnt(0)" ::: "memory");
  bf16_t* Ow = ATT + (size_t)(b * SEQ + 256 * I + wid * QBLK) * DM + h * D;
#pragma unroll
  for (int i = 0; i < 8; ++i) { const int row = i * 4 + (lane >> 4), ch = lane & 15; const u32x4 v = *(const u32x4*)(stg + row * 128 + ch * 8); *(u32x4*)(Ow + (size_t)row * DM + ch * 8) = v; }
  __syncthreads();
#undef SLOAD
#undef SWRITE
#undef SWAIT
#undef RESC
}
#undef KSWZ
#undef SBAR
}


namespace rt {
using mb::f32x16; using mb::s16x4; using mb::crow; using mb::cvtpk;
#define SBAR() __builtin_amdgcn_sched_barrier(0)
__device__ __forceinline__ unsigned off_a(unsigned row, unsigned ch) { return 2048u * (row >> 3) + 512u * (ch >> 2) + 64u * (row & 7) + 16u * ((ch & 3) ^ ((row >> 2) & 3)); }
template <int OFF> __device__ __forceinline__ s16x4 trr(unsigned addr) { s16x4 r; asm volatile("ds_read_b64_tr_b16 %0, %1 offset:%2" : "=&v"(r) : "v"(addr), "i"(OFF) : "memory"); return r; }
__device__ __forceinline__ u32x4 scale8(u32x4 v, float f) {
  u32x4 o;
  o.x = cvtpk(__uint_as_float(v.x << 16) * f, __uint_as_float(v.x & 0xffff0000u) * f); o.y = cvtpk(__uint_as_float(v.y << 16) * f, __uint_as_float(v.y & 0xffff0000u) * f);
  o.z = cvtpk(__uint_as_float(v.z << 16) * f, __uint_as_float(v.z & 0xffff0000u) * f); o.w = cvtpk(__uint_as_float(v.w << 16) * f, __uint_as_float(v.w & 0xffff0000u) * f);
  return o;
}
__device__ __forceinline__ float lg2gamma(int hr) { return log2f(1.f - exp2f(-5.f - (float)hr)); }
#define PKF(L, H) (bf16x8){L[0], L[1], L[2], L[3], H[0], H[1], H[2], H[3]}

template <int KS> __device__ __forceinline__ void kv_step(f32x16 (&acc)[8], unsigned bv0, unsigned bv1, unsigned bk0, unsigned bk1) {
  const s16x4 al = trr<4096 * KS>(bv0), ah = trr<4096 * KS>(bv1);
  s16x4 bl[8], bh[8];
#define RD(cb) bl[cb] = trr<4096 * KS + 512 * (cb & 3) + 32768 * (cb >> 2)>(bk0); bh[cb] = trr<4096 * KS + 512 * (cb & 3) + 32768 * (cb >> 2)>(bk1);
  RD(0) RD(1) RD(2) RD(3) RD(4) RD(5) RD(6) RD(7)
#undef RD
  asm volatile("s_waitcnt lgkmcnt(0)" ::: "memory"); SBAR();
  const bf16x8 a = PKF(al, ah);
#pragma unroll
  for (int cb = 0; cb < 8; ++cb) acc[cb] = __builtin_amdgcn_mfma_f32_32x32x16_bf16(a, PKF(bl[cb], bh[cb]), acc[cb], 0, 0, 0);
}
__device__ __forceinline__ void kv_unit(int b, int hr, int n, const bf16_t* __restrict__ PROJ, bf16_t* __restrict__ ST, char* lds) {
  int tid_ = threadIdx.x; asm volatile("" : "+v"(tid_));
  const int tid = tid_, wid = __builtin_amdgcn_readfirstlane(tid >> 6), lane = tid & 63, r32 = lane & 31, hi = lane >> 5;
  const float L2G = lg2gamma(hr);
  const bf16_t* Kg = PROJ + (size_t)(b * SEQ + n * 128) * INW + C_KR + hr * RD;
  const bf16_t* Vg = PROJ + (size_t)(b * SEQ + n * 128) * INW + C_VR + hr * RD;
#pragma unroll
  for (int i = 0; i < 8; ++i) { const int idx = tid + 512 * i, row = idx >> 5, c32 = idx & 31, img = c32 >> 4, ch = c32 & 15;
    const u32x4 kv = *(const u32x4*)(Kg + (size_t)row * INW + c32 * 8); u32x4 vv = *(const u32x4*)(Vg + (size_t)row * INW + c32 * 8);
    vv = scale8(vv, exp2f(L2G * (float)(127 - row)) * 0.0625f);
    *(u32x4*)(lds + img * 32768 + off_a(row, ch)) = vv; *(u32x4*)(lds + 65536 + img * 32768 + off_a(row, ch)) = kv; }
  __syncthreads();
  f32x16 acc[8];
#pragma unroll
  for (int cb = 0; cb < 8; ++cb) acc[cb] = f32x16{};
  const unsigned q = (lane & 15) >> 2, p = lane & 3, blk = (lane >> 4) & 1;
  const unsigned lp = 2048u * hi + 64u * q + 8u * (p & 1), x2 = 2u * blk + (p >> 1);
  const unsigned o0 = lp + 16u * (x2 ^ ((2u * hi) & 3u)), o1 = lp + 256u + 16u * (x2 ^ ((2u * hi + 1u) & 3u));
  const unsigned l0 = (unsigned)(uintptr_t)lds;
  const unsigned bv0 = l0 + o0 + 512u * (wid & 3) + 32768u * (wid >> 2), bv1 = l0 + o1 + 512u * (wid & 3) + 32768u * (wid >> 2);
  const unsigned bk0 = l0 + 65536u + o0, bk1 = l0 + 65536u + o1;
  kv_step<0>(acc, bv0, bv1, bk0, bk1); kv_step<1>(acc, bv0, bv1, bk0, bk1); kv_step<2>(acc, bv0, bv1, bk0, bk1); kv_step<3>(acc, bv0, bv1, bk0, bk1);
  kv_step<4>(acc, bv0, bv1, bk0, bk1); kv_step<5>(acc, bv0, bv1, bk0, bk1); kv_step<6>(acc, bv0, bv1, bk0, bk1); kv_step<7>(acc, bv0, bv1, bk0, bk1);
  __syncthreads();
  char* stg = lds + wid * 16384;
#pragma unroll
  for (int cb = 0; cb < 8; ++cb)
#pragma unroll
    for (int r = 0; r < 16; ++r) { const int row = crow(r, hi), chunk = cb * 4 + (r32 >> 3);
      *(bf16_t*)(stg + row * 512 + ((chunk ^ row) << 4) + (r32 & 7) * 2) = (bf16_t)f2bf(acc[cb][r]); }
  asm volatile("s_waitcnt lgkmcnt(0)" ::: "memory");
  bf16_t* dst = ST + ((size_t)((b * RH + hr) * 31 + n)) * 65536 + (size_t)(((wid >> 2) * 4 + (wid & 3)) * 16) * 512;
#pragma unroll
  for (int d0 = 0; d0 < 16; ++d0) { const u32x4 v = *(const u32x4*)(stg + r32 * 512 + (((2 * d0 + hi) ^ r32) << 4)); *(u32x4*)(dst + (size_t)d0 * 512 + lane * 8) = v; }
  __syncthreads();
}

constexpr int CH_NDV = 4;
template <int KS> __device__ __forceinline__ void ch_kstep(s16x4& kl, s16x4& kh, s16x4 (&vl)[CH_NDV], s16x4 (&vh)[CH_NDV], unsigned bk0, unsigned bk1, unsigned bv0, unsigned bv1) {
  kl = trr<4096 * KS>(bk0); kh = trr<4096 * KS>(bk1);
  vl[0] = trr<4096 * KS>(bv0); vh[0] = trr<4096 * KS>(bv1);
  if constexpr (CH_NDV > 1) { vl[1] = trr<4096 * KS + 512>(bv0); vh[1] = trr<4096 * KS + 512>(bv1); }
  if constexpr (CH_NDV > 2) { vl[2] = trr<4096 * KS + 1024>(bv0); vh[2] = trr<4096 * KS + 1024>(bv1); vl[3] = trr<4096 * KS + 1536>(bv0); vh[3] = trr<4096 * KS + 1536>(bv1); }
}
__device__ __forceinline__ void kvchain_unit(int b, int hr, int sl, const bf16_t* __restrict__ PROJ, bf16_t* __restrict__ ST, char* lds) {
  int tid_ = threadIdx.x; asm volatile("" : "+v"(tid_));
  const int tid = tid_, wid = __builtin_amdgcn_readfirstlane(tid >> 6), lane = tid & 63, hi = lane >> 5;
  const float L2G = lg2gamma(hr), cd = exp2f(128.f * L2G);
  const bf16_t* Kg = PROJ + (size_t)(b * SEQ) * INW + C_KR + hr * RD;
  const bf16_t* Vg = PROJ + (size_t)(b * SEQ) * INW + C_VR + hr * RD + sl * (32 * CH_NDV);
  const int vrow = tid >> 2, vc4 = tid & 3;
  const float vscale = exp2f(L2G * (float)(127 - vrow)) * 0.0625f;
  struct ChBuf { u32x4 k[8]; u32x4 v[CH_NDV]; } bufA;
#define CH_LOAD(buf, n_) do { const bf16_t* kp_ = Kg + (size_t)((n_) * 128) * INW; const bf16_t* vp_ = Vg + (size_t)((n_) * 128) * INW; \
    _Pragma("unroll") for (int i = 0; i < 8; ++i) { const int idx = tid + 512 * i, row = idx >> 5, c32 = idx & 31; buf.k[i] = *(const u32x4*)(kp_ + (size_t)row * INW + c32 * 8); } \
    _Pragma("unroll") for (int j = 0; j < CH_NDV; ++j) buf.v[j] = *(const u32x4*)(vp_ + (size_t)vrow * INW + (vc4 + 4 * j) * 8); } while (0)
#define CH_WRITE(buf) do { _Pragma("unroll") for (int i = 0; i < 8; ++i) { const int idx = tid + 512 * i, row = idx >> 5, c32 = idx & 31, img = c32 >> 4, ch = c32 & 15; \
      *(u32x4*)(lds + 65536 + img * 32768 + off_a(row, ch)) = buf.k[i]; } \
    _Pragma("unroll") for (int j = 0; j < CH_NDV; ++j) { const int c32 = sl * (4 * CH_NDV) + vc4 + 4 * j; \
      *(u32x4*)(lds + (c32 >> 4) * 32768 + off_a(vrow, c32 & 15)) = scale8(buf.v[j], vscale); } } while (0)
  const unsigned q = (lane & 15) >> 2, p = lane & 3, blk = (lane >> 4) & 1;
  const unsigned lp = 2048u * hi + 64u * q + 8u * (p & 1), x2 = 2u * blk + (p >> 1);
  const unsigned o0 = lp + 16u * (x2 ^ ((2u * hi) & 3u)), o1 = lp + 256u + 16u * (x2 ^ ((2u * hi + 1u) & 3u));
  const unsigned l0 = (unsigned)(uintptr_t)lds;
  const unsigned vb_ = (unsigned)(sl * CH_NDV);
  const unsigned bv0 = l0 + o0 + 512u * (vb_ & 3u) + 32768u * (vb_ >> 2), bv1 = l0 + o1 + 512u * (vb_ & 3u) + 32768u * (vb_ >> 2);
  const unsigned bk0 = l0 + 65536u + o0 + 512u * (wid & 3) + 32768u * (wid >> 2), bk1 = l0 + 65536u + o1 + 512u * (wid & 3) + 32768u * (wid >> 2);
  f32x16 acc[CH_NDV];
#pragma unroll
  for (int m = 0; m < CH_NDV; ++m) acc[m] = f32x16{};
  bf16_t* dst0 = ST + ((size_t)((b * RH + hr) * 31)) * 65536 + (size_t)(sl * CH_NDV * 16 + 2 * wid) * 512 + lane * 8;
#define CH_PK4(P, BASE, OUT) do { unsigned a0 = cvtpk(P[BASE + 0], P[BASE + 1]), a1 = cvtpk(P[BASE + 2], P[BASE + 3]);   \
    unsigned b0 = cvtpk(P[BASE + 4], P[BASE + 5]), b1 = cvtpk(P[BASE + 6], P[BASE + 7]);                              \
    auto r0 = __builtin_amdgcn_permlane32_swap(a0, b0, false, false); auto r1 = __builtin_amdgcn_permlane32_swap(a1, b1, false, false); \
    OUT = (u32x4){r0[0], r1[0], r0[1], r1[1]}; } while (0)
#define CH_PART(KS0) do { s16x4 kl[2], kh_[2], vl[2][CH_NDV], vh[2][CH_NDV]; \
    ch_kstep<(KS0)>(kl[0], kh_[0], vl[0], vh[0], bk0, bk1, bv0, bv1); ch_kstep<(KS0) + 1>(kl[1], kh_[1], vl[1], vh[1], bk0, bk1, bv0, bv1); \
    asm volatile("s_waitcnt lgkmcnt(0)" ::: "memory"); SBAR(); \
    _Pragma("unroll") for (int ks = 0; ks < 2; ++ks) _Pragma("unroll") for (int m = 0; m < CH_NDV; ++m) \
      acc[m] = __builtin_amdgcn_mfma_f32_32x32x16_bf16(PKF(kl[ks], kh_[ks]), PKF(vl[ks][m], vh[ks][m]), acc[m], 0, 0, 0); } while (0)
#define CH_STEP(buf, n_) do { \
    __syncthreads(); \
    CH_WRITE(buf); \
    if ((n_) + 1 < 31) CH_LOAD(buf, (n_) + 1); \
    _Pragma("unroll") for (int m = 0; m < CH_NDV; ++m) _Pragma("unroll") for (int r = 0; r < 16; ++r) acc[m][r] *= cd; \
    __syncthreads(); \
    CH_PART(0); CH_PART(2); CH_PART(4); CH_PART(6); \
    { bf16_t* dst = dst0 + (size_t)(n_) * 65536; \
      _Pragma("unroll") for (int m = 0; m < CH_NDV; ++m) { u32x4 f0, f1; CH_PK4(acc[m], 0, f0); CH_PK4(acc[m], 8, f1); \
        *(u32x4*)(dst + (size_t)(m * 16) * 512) = f0; *(u32x4*)(dst + (size_t)(m * 16 + 1) * 512) = f1; } } \
  } while (0)
  static_assert(CH_NDV == 1 || CH_NDV == 2 || CH_NDV == 4, "a slice must not straddle an LDS image");
  if (__builtin_amdgcn_readfirstlane(tid) >= 256) __builtin_amdgcn_s_setprio(1);
  CH_LOAD(bufA, 0);
#pragma unroll 1
  for (int n = 0; n < 31; ++n) CH_STEP(bufA, n);
  __builtin_amdgcn_s_setprio(0);
  __syncthreads();
#undef CH_STEP
#undef CH_PART
#undef CH_PK4
#undef CH_LOAD
#undef CH_WRITE
}

#define KSWZ16(row, colB) ((row) * 512 + ((colB) ^ (((row) & 15) << 4)))
template <int KT> __device__ __forceinline__ void ret_intra(f32x16* o, const bf16x8* qr, const char* Kl, int vb, int irow, int hi, int r32, float L2G) {
  f32x16 p0 = f32x16{}, p1 = f32x16{};
#pragma unroll
  for (int d0 = 0; d0 < 16; ++d0) { const int cb = (d0 * 16 + hi * 8) * 2;
    const bf16x8 b0 = *reinterpret_cast<const bf16x8*>(Kl + KSWZ16(64 * KT + r32, cb));
    const bf16x8 b1 = *reinterpret_cast<const bf16x8*>(Kl + KSWZ16(64 * KT + 32 + r32, cb));
    p0 = __builtin_amdgcn_mfma_f32_32x32x16_bf16(b0, qr[d0], p0, 0, 0, 0);
    p1 = __builtin_amdgcn_mfma_f32_32x32x16_bf16(b1, qr[d0], p1, 0, 0, 0);
    if ((d0 & 3) == 3) { asm volatile("" ::: "memory"); SBAR(); } }
  const int dbase = irow - 64 * KT - 4 * hi; float lg = L2G; asm volatile("" : "+v"(lg));
#pragma unroll
  for (int r = 0; r < 16; ++r) { const int c = (r & 3) + 8 * (r >> 2); const int d0_ = dbase - c, d1_ = dbase - c - 32;
    p0[r] = (d0_ >= 0) ? p0[r] * (__builtin_amdgcn_exp2f(lg * (float)d0_) * 0.0625f) : 0.f;
    p1[r] = (d1_ >= 0) ? p1[r] * (__builtin_amdgcn_exp2f(lg * (float)d1_) * 0.0625f) : 0.f; }
  bf16x8 pa0, pa1, pa2, pa3;
#define PK4(P, BASE, OUT) do { unsigned a0 = cvtpk(P[BASE + 0], P[BASE + 1]), a1 = cvtpk(P[BASE + 2], P[BASE + 3]);   \
    unsigned b0 = cvtpk(P[BASE + 4], P[BASE + 5]), b1 = cvtpk(P[BASE + 6], P[BASE + 7]);                              \
    auto r0 = __builtin_amdgcn_permlane32_swap(a0, b0, false, false); auto r1 = __builtin_amdgcn_permlane32_swap(a1, b1, false, false); \
    u32x4 w = {r0[0], r1[0], r0[1], r1[1]}; OUT = *reinterpret_cast<bf16x8*>(&w); } while (0)
  PK4(p0, 0, pa0); PK4(p0, 8, pa1); PK4(p1, 0, pa2); PK4(p1, 8, pa3);
#undef PK4
  mb::pv_d0(o, vb, pa0, pa1, pa2, pa3);
}
template <int STOP> __device__ __forceinline__ void ret_unit(int b, int hr, int n, const bf16_t* __restrict__ PROJ, const bf16_t* __restrict__ ST, const float* __restrict__ ret_norm_w,
                                         bf16_t* __restrict__ ATT, char* lds, float* ssx) {
  int tid_ = threadIdx.x; asm volatile("" : "+v"(tid_));
  const int tid = tid_, wid = __builtin_amdgcn_readfirstlane(tid >> 6), lane = tid & 63, r32 = lane & 31, hi = lane >> 5, rg = wid >> 1, dh = wid & 1;
  const float L2G = lg2gamma(hr);
  if (__builtin_amdgcn_readfirstlane(tid) >= 256) __builtin_amdgcn_s_setprio(1);
  const size_t row0 = (size_t)(b * SEQ + n * 128);
  const bf16_t* Qg = PROJ + row0 * INW + C_QR + hr * RD;
  const bf16_t* Kg = PROJ + row0 * INW + C_KR + hr * RD;
  const bf16_t* Vg = PROJ + row0 * INW + C_VR + hr * RD;
  u32x4 kvr[8], vvr[8];
#pragma unroll
  for (int i = 0; i < 8; ++i) { const int idx = tid + 512 * i, row = idx >> 5, c = (idx & 31) * 8;
    kvr[i] = *(const u32x4*)(Kg + (size_t)row * INW + c); vvr[i] = *(const u32x4*)(Vg + (size_t)row * INW + c); }
  bf16x8 qr[16];
  { const bf16_t* Qw = Qg + (size_t)(rg * 32 + r32) * INW + hi * 8;
#pragma unroll
    for (int d0 = 0; d0 < 16; ++d0) qr[d0] = *reinterpret_cast<const bf16x8*>(Qw + d0 * 16); }
  const bf16_t* Sg = ST + ((size_t)((b * RH + hr) * 31 + (n > 0 ? n - 1 : 0))) * 65536 + (size_t)(dh * 4 * 16) * 512 + lane * 8;
#define LDF(dst, d0_) do { _Pragma("unroll") for (int c = 0; c < 4; ++c) dst[c] = *reinterpret_cast<const bf16x8*>(Sg + (size_t)(c * 16 + (d0_)) * 512); } while (0)
#define MMF(src, d0_) do { _Pragma("unroll") for (int c = 0; c < 4; ++c) o[c] = __builtin_amdgcn_mfma_f32_32x32x16_bf16(qr[d0_], src[c], o[c], 0, 0, 0); } while (0)
  bf16x8 fA[4], fB[4], fC[4], fD[4];
  if (n > 0) { LDF(fA, 0); LDF(fB, 1); LDF(fC, 2); }
  asm volatile("" ::: "memory");
#pragma unroll
  for (int i = 0; i < 8; ++i) { const int idx = tid + 512 * i, row = idx >> 5, c = (idx & 31) * 8;
    *(u32x4*)(lds + 65536 + KSWZ16(row, c * 2)) = kvr[i];
    *(u32x4*)(lds + ((row >> 6) * 2 + (c >> 7)) * 16384 + mb::v_st(row & 63, c & 127)) = vvr[i]; }
  f32x16 o[4];
#pragma unroll
  for (int c = 0; c < 4; ++c) o[c] = f32x16{};
  if constexpr (STOP == 1) { _Pragma("unroll") for (int d0 = 0; d0 < 16; ++d0) asm volatile("" :: "v"(qr[d0])); __syncthreads(); return; }
  if (n > 0) {
    LDF(fD, 3); asm volatile("" ::: "memory"); MMF(fA, 0);
    LDF(fA, 4); asm volatile("" ::: "memory"); MMF(fB, 1);
    LDF(fB, 5); asm volatile("" ::: "memory"); MMF(fC, 2);
    LDF(fC, 6); asm volatile("" ::: "memory"); MMF(fD, 3);
    LDF(fD, 7); asm volatile("" ::: "memory"); MMF(fA, 4);
    LDF(fA, 8); asm volatile("" ::: "memory"); MMF(fB, 5);
    LDF(fB, 9); asm volatile("" ::: "memory"); MMF(fC, 6);
    LDF(fC, 10); asm volatile("" ::: "memory"); MMF(fD, 7);
    LDF(fD, 11); asm volatile("" ::: "memory"); MMF(fA, 8);
    LDF(fA, 12); asm volatile("" ::: "memory"); MMF(fB, 9);
    LDF(fB, 13); asm volatile("" ::: "memory"); MMF(fC, 10);
    LDF(fC, 14); asm volatile("" ::: "memory"); MMF(fD, 11);
    LDF(fD, 15); asm volatile("" ::: "memory"); MMF(fA, 12);
    MMF(fB, 13); MMF(fC, 14); MMF(fD, 15);
#undef LDF
#undef MMF
#pragma unroll
    for (int r = 0; r < 16; ++r) { const float f = __builtin_amdgcn_exp2f(L2G * (float)(rg * 32 + crow(r, hi) + 1));
#pragma unroll
      for (int c = 0; c < 4; ++c) o[c][r] *= f; }
  }
  __syncthreads();
  if constexpr (STOP == 2) { _Pragma("unroll") for (int c = 0; c < 4; ++c) asm volatile("" :: "v"(o[c])); return; }
  const int vb0 = (int)(uintptr_t)lds + mb::v_rd_base(lane);
  const char* Kl = lds + 65536;
  const int irow = rg * 32 + r32;
  ret_intra<0>(o, qr, Kl, vb0 + dh * 16384, irow, hi, r32, L2G);
  if (rg >= 2) ret_intra<1>(o, qr, Kl, vb0 + (2 + dh) * 16384, irow, hi, r32, L2G);
  if constexpr (STOP == 3) { _Pragma("unroll") for (int c = 0; c < 4; ++c) asm volatile("" :: "v"(o[c])); __syncthreads(); return; }
  const int ccol = hr * RD + dh * 128;
  u32x4 gv[8];
#pragma unroll
  for (int i = 0; i < 8; ++i) gv[i] = *(const u32x4*)(PROJ + (row0 + rg * 32 + i * 4 + (lane >> 4)) * INW + C_GR + ccol + (lane & 15) * 8);
#pragma unroll
  for (int r = 0; r < 16; ++r) { float s = 0.f;
#pragma unroll
    for (int c = 0; c < 4; ++c) s += o[c][r] * o[c][r];
    s += __shfl_xor(s, 1); s += __shfl_xor(s, 2); s += __shfl_xor(s, 4); s += __shfl_xor(s, 8); s += __shfl_xor(s, 16);
    if (r32 == 0) ssx[(rg * 2 + dh) * 32 + crow(r, hi)] = s; }
  __syncthreads();
  bf16_t* stg = (bf16_t*)(lds + wid * 8192);
#pragma unroll
  for (int r = 0; r < 16; ++r) { const int rr = crow(r, hi); const float rs = rsqrtf((ssx[(rg * 2) * 32 + rr] + ssx[(rg * 2 + 1) * 32 + rr]) * (1.f / RD) + EPS);
#pragma unroll
    for (int c = 0; c < 4; ++c) stg[rr * 128 + c * 32 + r32] = (bf16_t)f2bf(o[c][r] * rs); }
  asm volatile("s_waitcnt lgkmcnt(0)" ::: "memory");
#pragma unroll
  for (int i = 0; i < 8; ++i) { const int row = i * 4 + (lane >> 4), ch = lane & 15;
    const u32x4 v = *(const u32x4*)(stg + row * 128 + ch * 8);
    const u32x4 g = gv[i];
    const f32x4 w0 = *(const f32x4*)(ret_norm_w + ccol + ch * 8), w1 = *(const f32x4*)(ret_norm_w + ccol + ch * 8 + 4);
#define E2(vw, gw, wa, wb) cvtpk(__uint_as_float((vw) << 16) * (wa) * pg8::silu_fast(__uint_as_float((gw) << 16)), __uint_as_float((vw) & 0xffff0000u) * (wb) * pg8::silu_fast(__uint_as_float((gw) & 0xffff0000u)))
    u32x4 ov; ov.x = E2(v.x, g.x, w0.x, w0.y); ov.y = E2(v.y, g.y, w0.z, w0.w); ov.z = E2(v.z, g.z, w1.x, w1.y); ov.w = E2(v.w, g.w, w1.z, w1.w);
#undef E2
    *(u32x4*)(ATT + (row0 + rg * 32 + row) * DM + AW + ccol + ch * 8) = ov; }
  __builtin_amdgcn_s_setprio(0);
  __syncthreads();
}
#undef KSWZ16
#undef PKF
#undef SBAR
}

struct Args { const float* in[17]; float* out; unsigned char* ws; int ph_lo, ph_hi, li, pad; };
constexpr int CH_PER = 8 / rt::CH_NDV, NQ_ATT = NB * AH * 16, NQ_CH = NB * RH * CH_PER, CH_COST = 14;
struct AttTab { unsigned short v[NQ_ATT + NQ_CH]; };
constexpr AttTab make_att_tab() {
    AttTab t{}; const int keep[AH] = {2, 3, 5, 10, 16, 16, 16, 16}; int n = 0;
    for (int c = 17; c >= 1; --c) {
        if (c == CH_COST) for (int k = 0; k < NQ_CH; ++k) t.v[n++] = (unsigned short)(NQ_ATT + k);
        for (int u = 0; u < NQ_ATT; ++u) { const int I = u & 15, h = (u >> 4) & 7; const int cu = (I < keep[h] ? I : keep[h]) + 1; if (cu == c) t.v[n++] = (unsigned short)u; } }
    return t;
}
__device__ const AttTab ATT_TAB = make_att_tab();

struct Frame {
    LAS unsigned char* lds; volatile LAS unsigned* MISC; unsigned* ctl;
    int tid, lane, wave, G, vcu;
};
__device__ __forceinline__ float wave_sum(float v) {
#pragma unroll
    for (int o = 1; o < 64; o <<= 1) v += __shfl_xor(v, o);
    return v;
}
struct TrItem { const float* W; void* WT; int N, k0, n0, ldk; long drow; float scale; };
__device__ __forceinline__ void tr_load(const TrItem& d, float (&tv)[32], int lane) {
#pragma unroll
    for (int i = 0; i < 32; ++i) tv[i] = d.W[(size_t)(d.k0 + 2 * i + (lane >> 5)) * d.N + d.n0 + (lane & 31)];
}
__device__ __forceinline__ void tr_finish(const TrItem& d, const float (&tv)[32], LAS float* scr, int lane) {
#pragma unroll
    for (int i = 0; i < 32; ++i) scr[(2 * i + (lane >> 5)) * 33 + (lane & 31)] = tv[i];
    LDS_WAIT(); asm volatile("" ::: "memory");
    if (d.scale == 0.f) {
        const int c = lane & 7;
#pragma unroll
        for (int j = 0; j < 4; ++j) { const int n = (lane >> 3) + 8 * j; const LAS float* s = scr + (8 * c) * 33 + n;
            u32x4 o; o.x = pg8::cvt_pk_bf16(s[0 * 33], s[1 * 33]); o.y = pg8::cvt_pk_bf16(s[2 * 33], s[3 * 33]); o.z = pg8::cvt_pk_bf16(s[4 * 33], s[5 * 33]); o.w = pg8::cvt_pk_bf16(s[6 * 33], s[7 * 33]);
            *(u32x4*)((bf16_t*)d.WT + (size_t)(d.drow + n) * d.ldk + d.k0 + 8 * c) = o; }
    } else {
        const int c = lane & 3; const float sc = d.scale;
#pragma unroll
        for (int j = 0; j < 2; ++j) { const int n = (lane >> 2) + 16 * j; const LAS float* s = scr + (16 * c) * 33 + n;
            u32x4 o; o.x = cvt4_fp8(s[0 * 33] * sc, s[1 * 33] * sc, s[2 * 33] * sc, s[3 * 33] * sc); o.y = cvt4_fp8(s[4 * 33] * sc, s[5 * 33] * sc, s[6 * 33] * sc, s[7 * 33] * sc);
            o.z = cvt4_fp8(s[8 * 33] * sc, s[9 * 33] * sc, s[10 * 33] * sc, s[11 * 33] * sc); o.w = cvt4_fp8(s[12 * 33] * sc, s[13 * 33] * sc, s[14 * 33] * sc, s[15 * 33] * sc);
            *(u32x4*)((unsigned char*)d.WT + (size_t)(d.drow + n) * d.ldk + d.k0 + 16 * c) = o; }
    }
    LDS_WAIT(); asm volatile("" ::: "memory");
}
#define TR_STREAM(DECODE, it0, step, itend) do { int it_ = (it0); float tvA[32], tvB[32]; TrItem dA, dB; \
    if (it_ < (itend)) { DECODE(dA, it_); tr_load(dA, tvA, F.lane); } \
    while (it_ < (itend)) { int nx_ = it_ + (step); if (nx_ < (itend)) { DECODE(dB, nx_); tr_load(dB, tvB, F.lane); } tr_finish(dA, tvA, scr, F.lane); it_ = nx_; if (it_ >= (itend)) break; \
        nx_ = it_ + (step); if (nx_ < (itend)) { DECODE(dA, nx_); tr_load(dA, tvA, F.lane); } tr_finish(dB, tvB, scr, F.lane); it_ = nx_; } } while (0)

__global__ void __launch_bounds__(NTHR, 2) mk_fwd(Args args) {
    extern __shared__ __attribute__((aligned(16))) unsigned char lds_raw[];
    Frame F;
    F.lds = (LAS unsigned char*)lds_raw;
    F.MISC = (volatile LAS unsigned*)(F.lds + MISC_OFF);
    F.tid = threadIdx.x; F.lane = F.tid & 63; F.wave = __builtin_amdgcn_readfirstlane(F.tid >> 6);
    F.G = gridDim.x; { const int bx = blockIdx.x; F.vcu = (F.G % 8 == 0) ? (bx % 8) * (F.G / 8) + bx / 8 : bx; }
    unsigned char* ws = args.ws;
    F.ctl = (unsigned*)(ws + WS_CTL);
    for (int u = F.tid; u < (LDS_BYTES - LDSCTL_OFF) / 4; u += NTHR) ((LAS unsigned*)(F.lds + LDSCTL_OFF))[u] = 0u;
    __syncthreads();
    XcdBarrier bar = xcd_barrier_post((unsigned*)(ws + WS_CTL + CTL_BAR) + args.li * 4096, F.MISC + 8);
    const int lo = args.ph_lo, hi = args.ph_hi;
#define IN(k) (lo <= (k) && (k) < hi)
#define REPS(k) ((k) == PROBE_PHASE ? 1 + PROBE_REPS : 1)
#define BOTH(k) (IN(k) && IN((k) + 1))
#define GRID_BAR() xcd_barrier(bar)
#define REFRESH() do { int t_ = threadIdx.x; asm volatile("" : "+v"(t_)); F.tid = t_; F.lane = t_ & 63; } while (0)
    const float* x = args.in[0]; const float* cvec = args.in[1]; const float* w_ada = args.in[2]; const float* b_ada = args.in[3];
    const float* norm_mix_w = args.in[4]; const float* w_in = args.in[5]; const float* w_out = args.in[7];
    const float* w_group = args.in[9]; const float* w_router = args.in[11];
    const float* w1 = args.in[13]; const float* w3 = args.in[14]; const float* w2 = args.in[15];
    float* modp = (float*)(ws + WS_MODP); float* mod = (float*)(ws + WS_MOD);
    bf16_t* Wt_in = (bf16_t*)(ws + WS_WIN); bf16_t* Wt_out = (bf16_t*)(ws + WS_WOUT); bf16_t* W13t = (bf16_t*)(ws + WS_W13); bf16_t* W2t = (bf16_t*)(ws + WS_W2);
    bf16_t* Hb = (bf16_t*)(ws + WS_H); bf16_t* PROJ = (bf16_t*)(ws + WS_PROJ); bf16_t* ATT = (bf16_t*)(ws + WS_ATT);
    float* kmean = (float*)(ws + WS_CTL + CTL_KMEAN);

    if (IN(0)) {
        REFRESH();
        _Pragma("unroll 1") for (int rep_ = 0; rep_ < REPS(0); ++rep_) {
        for (int it = blockIdx.x; it < 192; it += F.G) {
            const int kc = it / 12, cg = it % 12;
            LAS float* sc = (LAS float*)(F.lds + RING_OFF);
            { const int b = F.tid >> 7, kk = F.tid & 127; sc[b * 128 + kk] = silu_f(cvec[b * DM + kc * 128 + kk]); }
            __syncthreads();
            const int col = cg * 1024 + F.tid * 2;
            float a0[4] = {0.f, 0.f, 0.f, 0.f}, a1[4] = {0.f, 0.f, 0.f, 0.f};
            const float* wp = w_ada + (size_t)(kc * 128) * NMOD + col;
#pragma unroll 16
            for (int kk = 0; kk < 128; ++kk) { const float2 w = *(const float2*)(wp + (size_t)kk * NMOD);
#pragma unroll
                for (int b = 0; b < 4; ++b) { const float s = sc[b * 128 + kk]; a0[b] += s * w.x; a1[b] += s * w.y; } }
#pragma unroll
            for (int b = 0; b < 4; ++b) *(float2*)(modp + (size_t)(kc * 4 + b) * NMOD + col) = make_float2(a0[b], a1[b]);
            __syncthreads();
        }
        { bf16_t* WRh = (bf16_t*)(ws + WS_WR); bf16_t* WRl = WRh + 48 * DM;
          for (int idx = blockIdx.x * NTHR + F.tid; idx < DM * 48; idx += F.G * NTHR) { const int j = idx / DM, k = idx - j * DM;
              float v = 0.f; if (j < 4) v = w_group[k * 4 + j]; else if (j < 36) v = w_router[((size_t)((j - 4) >> 3) * DM + k) * 8 + ((j - 4) & 7)];
              const unsigned hb = f2bf(v); WRh[idx] = (bf16_t)hb; WRl[idx] = (bf16_t)f2bf(v - __uint_as_float(hb << 16)); } }
        { LAS float* scr = (LAS float*)(F.lds + RING_OFF + 4096 + F.wave * 8704);
          const int gw = F.vcu * NWAVES + F.wave, NGW = F.G * NWAVES;
          constexpr int I_IN = (DM / 64) * (INW / 32), I_OUT = (DM / 64) * (DM / 32), I_E13 = (DM / 64) * (DE / 32), I_E2 = (DE / 64) * (DM / 32);
          constexpr int NITEMS = I_IN + I_OUT + NE * (2 * I_E13);
#define P0_DECODE(d, it) do { int r = (it); \
              if (r < I_IN) { const int nblk = INW / 32, kb = r / nblk, nb = r % nblk; d = TrItem{w_in, Wt_in, INW, 64 * kb, 32 * nb, DM, (long)(32 * nb), 0.f}; } \
              else { r -= I_IN; if (r < I_OUT) { const int nblk = DM / 32, kb = r / nblk, nb = r % nblk; d = TrItem{w_out, Wt_out, DM, 64 * kb, 32 * nb, DM, (long)(32 * nb), 0.f}; } \
              else { r -= I_OUT; const int e = r / (2 * I_E13); r -= e * (2 * I_E13); const int which = r / I_E13; r -= which * I_E13; const int nblk = DE / 32, kb = r / nblk, nb = r % nblk, n0 = 32 * nb; \
                  d = TrItem{(which ? w3 : w1) + (size_t)e * DM * DE, W13t, DE, 64 * kb, n0, DM, (long)e * 1024 + (n0 >> 7) * 256 + which * 128 + (n0 & 127), W13_SCALE}; } } } while (0)
          TR_STREAM(P0_DECODE, gw, NGW, NITEMS);
#undef P0_DECODE
          }
        }
        if (BOTH(0)) GRID_BAR();
    }

    if (IN(1)) {
        REFRESH();
        _Pragma("unroll 1") for (int rep_ = 0; rep_ < REPS(1); ++rep_) {
        { const int idx = blockIdx.x * NTHR + F.tid;
          if (idx < NB * NMOD) { const int b = idx / NMOD, j = idx % NMOD; float s = b_ada[j];
#pragma unroll
              for (int kc = 0; kc < 16; ++kc) s += modp[(size_t)(kc * 4 + b) * NMOD + j];
              mod[idx] = s; } }
        LAS float* Am = (LAS float*)(F.lds + RING_OFF);
        LAS float* Sm = Am + DM;
        for (int rb = blockIdx.x; rb < MTOK / 64; rb += F.G) {
            const int b = (rb * 64) / SEQ;
            __syncthreads();
            for (int k = F.tid; k < DM; k += NTHR) { float sh = b_ada[k], sc = b_ada[DM + k];
#pragma unroll
                for (int kc = 0; kc < 16; ++kc) { sh += modp[(size_t)(kc * 4 + b) * NMOD + k]; sc += modp[(size_t)(kc * 4 + b) * NMOD + DM + k]; }
                Am[k] = norm_mix_w[k] * (1.f + sc); Sm[k] = sh; }
            __syncthreads();
            for (int r = F.wave; r < 64; r += 2 * NWAVES) {
                const int rowA = rb * 64 + r, rowB = rowA + NWAVES;
                const f32x4* xa = (const f32x4*)(x + (size_t)rowA * DM) + 2 * F.lane; const f32x4* xb = (const f32x4*)(x + (size_t)rowB * DM) + 2 * F.lane;
                f32x4 va[8], vb[8]; float sa = 0.f, sb = 0.f;
#pragma unroll
                for (int j = 0; j < 4; ++j) { va[2 * j] = xa[128 * j]; va[2 * j + 1] = xa[128 * j + 1]; vb[2 * j] = xb[128 * j]; vb[2 * j + 1] = xb[128 * j + 1]; }
#pragma unroll
                for (int j = 0; j < 8; ++j) { sa += (va[j].x * va[j].x + va[j].y * va[j].y) + (va[j].z * va[j].z + va[j].w * va[j].w); sb += (vb[j].x * vb[j].x + vb[j].y * vb[j].y) + (vb[j].z * vb[j].z + vb[j].w * vb[j].w); }
                const float ra = rsqrtf(wave_sum(sa) * (1.f / DM) + EPS), rbb = rsqrtf(wave_sum(sb) * (1.f / DM) + EPS);
                u32x4* oa = (u32x4*)(Hb + (size_t)rowA * DM) + F.lane; u32x4* ob = (u32x4*)(Hb + (size_t)rowB * DM) + F.lane;
#pragma unroll
                for (int j = 0; j < 4; ++j) { const int k = 8 * F.lane + 512 * j;
                    const f32x4 a0 = *(const LAS f32x4*)(Am + k), a1 = *(const LAS f32x4*)(Am + k + 4), s0 = *(const LAS f32x4*)(Sm + k), s1 = *(const LAS f32x4*)(Sm + k + 4);
                    const f32x4 p0 = va[2 * j] * ra * a0 + s0, p1 = va[2 * j + 1] * ra * a1 + s1, q0 = vb[2 * j] * rbb * a0 + s0, q1 = vb[2 * j + 1] * rbb * a1 + s1;
                    u32x4 w; w.x = pg8::cvt_pk_bf16(p0.x, p0.y); w.y = pg8::cvt_pk_bf16(p0.z, p0.w); w.z = pg8::cvt_pk_bf16(p1.x, p1.y); w.w = pg8::cvt_pk_bf16(p1.z, p1.w); oa[64 * j] = w;
                    u32x4 w2; w2.x = pg8::cvt_pk_bf16(q0.x, q0.y); w2.y = pg8::cvt_pk_bf16(q0.z, q0.w); w2.z = pg8::cvt_pk_bf16(q1.x, q1.y); w2.w = pg8::cvt_pk_bf16(q1.z, q1.w); ob[64 * j] = w2; }
            }
        }
        }
        if (BOTH(1)) GRID_BAR();
    }

    if (IN(2)) {
        REFRESH();
        __syncthreads();
        pg8::DenseOrder S; S.init(MTOK, INW, DM, F.G, (int)blockIdx.x);
        pg8::EpiProj E{PROJ, kmean, (int*)(ws + WS_CTL + CTL_CNT + 8192)};
        pg8::gemm_phase<pg8::EpiProj, pg8::DenseOrder>(F.lds + RING_OFF, Hb, Wt_in, DM * 2, S, E);
#if PROBE_PHASE == 2
        {
        __syncthreads();
        pg8::DenseOrder S; S.init(MTOK, INW, DM, F.G, (int)blockIdx.x);
        pg8::EpiProj E{PROJ, nullptr, nullptr};
        pg8::gemm_phase<pg8::EpiProj, pg8::DenseOrder>(F.lds + RING_OFF, Hb, Wt_in, DM * 2, S, E);
        }
#endif
        if (BOTH(2)) GRID_BAR();
    }

    bf16_t* STb = (bf16_t*)(ws + WS_H);
    if (IN(3)) {
        REFRESH();
        __syncthreads();
        char* albs = (char*)lds_raw + RING_OFF;
        const float* kn2f = (const float*)(ws + WS_CTL + CTL_CNT + 8192);
        if (F.G == 256) {
            unsigned* qa = (unsigned*)(ws + WS_CTL + CTL_CNT) + 128;
#pragma unroll 1
            for (;;) {
                __syncthreads();
                if (F.tid == 0) F.MISC[0] = __hip_atomic_fetch_add(qa, 1u, __ATOMIC_RELAXED, __HIP_MEMORY_SCOPE_AGENT);
                __syncthreads();
                const int q = __builtin_amdgcn_readfirstlane((int)F.MISC[0]);
                if (q >= NQ_ATT + NQ_CH) break;
                const int e = __builtin_amdgcn_readfirstlane((int)ATT_TAB.v[q]);
                if (e < NQ_ATT) { const int bh = e >> 4; mb::moba_unit(bh >> 3, bh & 7, e & 15, PROJ, kmean, kn2f, ATT, albs); }
                else { const int u = e - NQ_ATT; const int bh = u / CH_PER; rt::kvchain_unit(bh >> 2, bh & 3, u % CH_PER, PROJ, STb, albs); }
            }
        }
        if (F.G != 256) {
#pragma unroll 1
            for (int u = blockIdx.x; u < NQ_ATT + NQ_CH; u += F.G) {
                if (u < NQ_ATT) { const int bh = u >> 4; mb::moba_unit(bh >> 3, bh & 7, 15 - (u & 15), PROJ, kmean, kn2f, ATT, albs); }
                else { const int v = u - NQ_ATT; const int bh = v / CH_PER; rt::kvchain_unit(bh >> 2, bh & 3, v % CH_PER, PROJ, STb, albs); }
            }
        }
        if (hi > 5) GRID_BAR();
    }
    if (IN(6)) {
        REFRESH();
        _Pragma("unroll 1") for (int rep_ = 0; rep_ < REPS(6); ++rep_) {
        __syncthreads();
        char* albs = (char*)lds_raw + RING_OFF;
        float* ssx = (float*)((char*)lds_raw + LDSCTL_OFF + 2048);
#pragma unroll 1
        for (int u = blockIdx.x; u < NB * RH * 32; u += F.G) { const int bh = u >> 5, n = u & 31; if (rep_ == 0) rt::ret_unit<0>(bh >> 2, bh & 3, n, PROJ, STb, args.in[6], ATT, albs, ssx); else rt::ret_unit<PROBE_STOP>(bh >> 2, bh & 3, n, PROJ, STb, args.in[6], ATT, albs, ssx); }
        }
        if (BOTH(6)) GRID_BAR();
    }

    if (IN(7)) {
        REFRESH();
        __syncthreads();
        pg8::DenseOrder S; S.init(MTOK, DM, DM, F.G, (int)blockIdx.x);
        pg8::EpiOut E{x, mod, (bf16_t*)(ws + WS_X1), (float*)(ws + WS_MODP)};
        pg8::gemm_phase<pg8::EpiOut, pg8::DenseOrder>(F.lds + RING_OFF, ATT, Wt_out, DM * 2, S, E);
#if PROBE_PHASE == 7
        {
        __syncthreads();
        pg8::DenseOrder S; S.init(MTOK, DM, DM, F.G, (int)blockIdx.x);
        pg8::EpiOut E{x, mod, (bf16_t*)(ws + WS_X1), (float*)(ws + WS_MODP)};
        pg8::gemm_phase<pg8::EpiOut, pg8::DenseOrder>(F.lds + RING_OFF, ATT, Wt_out, DM * 2, S, E);
        }
#endif
        if (BOTH(7)) GRID_BAR();
    }

    if (IN(8)) {
        REFRESH();
        _Pragma("unroll 1") for (int rep_ = 0; rep_ < REPS(8); ++rep_) {
        constexpr int LDB = 72;
        LAS float* A2 = (LAS float*)(F.lds + RING_OFF);
        LAS float* S2 = A2 + DM;
        LAS bf16_t* wt = (LAS bf16_t*)(S2 + DM);
        LAS float* lgt = (LAS float*)(wt + 2 * 2 * 48 * LDB);
        LAS float* rst = lgt + 64 * 48;
        LAS int* hist = (LAS int*)(rst + 64);
        LAS int* hbase = hist + 32;
        LAS int* tk = hbase + 32;
        const bf16_t* WRh = (const bf16_t*)(ws + WS_WR); const bf16_t* WRl = WRh + 48 * DM;
        const bf16_t* x1 = (const bf16_t*)(ws + WS_X1);
        const float* b_group = args.in[10]; const float* b_router = args.in[12]; const float* norm_ffn_w = args.in[8];
        int* cnt = (int*)(ws + WS_CTL + CTL_CNT); int* elist = (int*)(ws + WS_ELIST); float* elistw = (float*)(ws + WS_ELISTW); int* tokslot = (int*)(ws + WS_TOKSLOT);
        for (int rb = blockIdx.x; rb < MTOK / 64; rb += F.G) {
            const int b = (rb * 64) / SEQ;
            __syncthreads();
            const int tg = F.wave & 3, kh = F.wave >> 2;
            const int li = F.lane & 15, kq = F.lane >> 4, arow = rb * 64 + 16 * tg + li, ak = 32 * kh + 8 * kq;
            u32x4 xw = *(const u32x4*)(x1 + (size_t)arow * DM + ak);
            const int wcol = F.tid >> 3, wku = F.tid & 7;
            u32x4 wvh = {0u, 0u, 0u, 0u}, wvl = {0u, 0u, 0u, 0u};
            if (F.tid < 384) { wvh = *(const u32x4*)(WRh + (size_t)wcol * DM + wku * 8); wvl = *(const u32x4*)(WRl + (size_t)wcol * DM + wku * 8); }
            { const float* rowss = (const float*)(ws + WS_MODP);
              if (F.tid < 64) { const f32x4* pr = (const f32x4*)(rowss + (size_t)(rb * 64 + F.tid) * 32); float sq = 0.f;
#pragma unroll
                  for (int j = 0; j < 8; ++j) { const f32x4 v = pr[j]; sq += (v.x + v.y) + (v.z + v.w); }
                  rst[F.tid] = rsqrtf(sq * (1.f / DM) + EPS); } }
            for (int k = F.tid; k < DM; k += NTHR) { A2[k] = norm_ffn_w[k] * (1.f + mod[(size_t)b * NMOD + 4 * DM + k]); S2[k] = mod[(size_t)b * NMOD + 3 * DM + k]; }
            if (F.tid < 32) hist[F.tid] = 0;
            __syncthreads();
            f32x4 lacc[3];
#pragma unroll
            for (int ct = 0; ct < 3; ++ct) lacc[ct] = (f32x4){0.f, 0.f, 0.f, 0.f};
            const float rs = rst[16 * tg + li];
            for (int kt = 0; kt < DM / 64; ++kt) {
                const int k0 = kt * 64;
                const f32x4 xa = {__uint_as_float(xw.x << 16), __uint_as_float(xw.x & 0xffff0000u), __uint_as_float(xw.y << 16), __uint_as_float(xw.y & 0xffff0000u)};
                const f32x4 xb = {__uint_as_float(xw.z << 16), __uint_as_float(xw.z & 0xffff0000u), __uint_as_float(xw.w << 16), __uint_as_float(xw.w & 0xffff0000u)};
                const f32x4 a0 = *(const LAS f32x4*)(A2 + k0 + ak), a1 = *(const LAS f32x4*)(A2 + k0 + ak + 4), s0 = *(const LAS f32x4*)(S2 + k0 + ak), s1 = *(const LAS f32x4*)(S2 + k0 + ak + 4);
                const f32x4 h0 = xa * rs * a0 + s0, h1 = xb * rs * a1 + s1;
                { u32x2 w; w.x = cvt4_fp8(h0.x, h0.y, h0.z, h0.w); w.y = cvt4_fp8(h1.x, h1.y, h1.z, h1.w);
                  *(u32x2*)((unsigned char*)Hb + (size_t)arow * DM + k0 + ak) = w; }
                u32x4 ah, al;
                ah.x = pg8::cvt_pk_bf16(h0.x, h0.y); ah.y = pg8::cvt_pk_bf16(h0.z, h0.w); ah.z = pg8::cvt_pk_bf16(h1.x, h1.y); ah.w = pg8::cvt_pk_bf16(h1.z, h1.w);
                al.x = pg8::cvt_pk_bf16(h0.x - __uint_as_float(ah.x << 16), h0.y - __uint_as_float(ah.x & 0xffff0000u)); al.y = pg8::cvt_pk_bf16(h0.z - __uint_as_float(ah.y << 16), h0.w - __uint_as_float(ah.y & 0xffff0000u));
                al.z = pg8::cvt_pk_bf16(h1.x - __uint_as_float(ah.z << 16), h1.y - __uint_as_float(ah.z & 0xffff0000u)); al.w = pg8::cvt_pk_bf16(h1.z - __uint_as_float(ah.w << 16), h1.w - __uint_as_float(ah.w & 0xffff0000u));
                LAS bf16_t* wtb = wt + (kt & 1) * (2 * 48 * LDB);
                if (F.tid < 384) { *(LAS u32x4*)(wtb + wcol * LDB + wku * 8) = wvh; *(LAS u32x4*)(wtb + 48 * LDB + wcol * LDB + wku * 8) = wvl; }
                if (kt + 1 < DM / 64) { xw = *(const u32x4*)(x1 + (size_t)arow * DM + k0 + 64 + ak);
                    if (F.tid < 384) { wvh = *(const u32x4*)(WRh + (size_t)wcol * DM + k0 + 64 + wku * 8); wvl = *(const u32x4*)(WRl + (size_t)wcol * DM + k0 + 64 + wku * 8); } }
                __syncthreads();
                const bf16x8 av_h = *reinterpret_cast<const bf16x8*>(&ah), av_l = *reinterpret_cast<const bf16x8*>(&al);
#pragma unroll
                for (int ct = 0; ct < 3; ++ct) { const LAS bf16_t* bp = wtb + (16 * ct + li) * LDB + ak;
                    const bf16x8 bh_ = *(const LAS bf16x8*)bp, bl_ = *(const LAS bf16x8*)(bp + 48 * LDB);
                    lacc[ct] = __builtin_amdgcn_mfma_f32_16x16x32_bf16(av_h, bh_, lacc[ct], 0, 0, 0);
                    lacc[ct] = __builtin_amdgcn_mfma_f32_16x16x32_bf16(av_h, bl_, lacc[ct], 0, 0, 0);
                    lacc[ct] = __builtin_amdgcn_mfma_f32_16x16x32_bf16(av_l, bh_, lacc[ct], 0, 0, 0); }
            }
            __syncthreads();
            if (kh == 1) {
#pragma unroll
                for (int ct = 0; ct < 3; ++ct)
#pragma unroll
                    for (int r = 0; r < 4; ++r) lgt[(16 * tg + 4 * (F.lane >> 4) + r) * 48 + 16 * ct + (F.lane & 15)] = lacc[ct][r];
            }
            __syncthreads();
            if (kh == 0) {
#pragma unroll
                for (int ct = 0; ct < 3; ++ct)
#pragma unroll
                    for (int r = 0; r < 4; ++r) lgt[(16 * tg + 4 * (F.lane >> 4) + r) * 48 + 16 * ct + (F.lane & 15)] += lacc[ct][r];
            }
            __syncthreads();
            if (rep_ == 0) {
            if (F.tid < 64) {
                LAS float* lg = lgt + F.tid * 48; const int token = rb * 64 + F.tid;
                float g0 = lg[0] + b_group[0]; int gs = 0; float gl[4]; gl[0] = g0;
#pragma unroll
                for (int i = 1; i < 4; ++i) { gl[i] = lg[i] + b_group[i]; if (gl[i] > g0) { g0 = gl[i]; gs = i; } }
                float gsum = 0.f;
#pragma unroll
                for (int i = 0; i < 4; ++i) gsum += __expf(gl[i] - g0);
                const float gw = 1.f / gsum;
                LAS float* el = lg + 4 + gs * 8; const float* br = b_router + gs * 8;
                float em = -INFINITY;
#pragma unroll
                for (int i = 0; i < 8; ++i) { const float v = el[i] + br[i]; el[i] = v; em = fmaxf(em, v); }
                float esum = 0.f;
#pragma unroll
                for (int i = 0; i < 8; ++i) { const float pe = __expf(el[i] - em); el[i] = pe; esum += pe; }
                int i1 = 0; float p1 = el[0];
#pragma unroll
                for (int i = 1; i < 8; ++i) if (el[i] > p1) { p1 = el[i]; i1 = i; }
                int i2 = -1; float p2 = -1.f;
#pragma unroll
                for (int i = 0; i < 8; ++i) if (i != i1 && el[i] > p2) { p2 = el[i]; i2 = i; }
                p1 /= esum; p2 /= esum;
                const int e0 = gs * 8 + i1, e1 = gs * 8 + i2;
                const int q0 = __hip_atomic_fetch_add(&hist[e0], 1, __ATOMIC_RELAXED, __HIP_MEMORY_SCOPE_WORKGROUP), q1 = __hip_atomic_fetch_add(&hist[e1], 1, __ATOMIC_RELAXED, __HIP_MEMORY_SCOPE_WORKGROUP);
                tk[F.tid * 4 + 0] = e0; tk[F.tid * 4 + 1] = e1; tk[F.tid * 4 + 2] = q0; tk[F.tid * 4 + 3] = q1;
                lg[36] = gw * p1 / (p1 + p2); lg[37] = gw * p2 / (p1 + p2);
                (void)token;
            }
            __syncthreads();
            if (F.tid < 32) { const int n = hist[F.tid]; hbase[F.tid] = n ? atomicAdd(cnt + F.tid, n) : 0; }
            __syncthreads();
            if (F.tid < 128) { const int tl = F.tid >> 1, sl = F.tid & 1, token = rb * 64 + tl;
                const int e = tk[tl * 4 + sl], pos = hbase[e] + tk[tl * 4 + 2 + sl];
                elist[e * LCAP + pos] = token * 2 + sl; elistw[e * LCAP + pos] = lgt[tl * 48 + 36 + sl]; tokslot[token * 2 + sl] = (e << 16) | pos; }
            }
        }
        }
        if (BOTH(8)) GRID_BAR();
    }

    constexpr int MOE_OFF = LDSCTL_OFF + 1024;
    LAS int* mtabs = (LAS int*)(F.lds + MOE_OFF);
    if (IN(9) || IN(10) || IN(11)) {
        REFRESH();
        const int* cnt = (const int*)(ws + WS_CTL + CTL_CNT);
        __syncthreads();
        if (F.tid == 0) { int so = 0, st = 0; for (int e = 0; e < NE; ++e) { const int ce = cnt[e]; mtabs[e] = so; mtabs[33 + e] = st; so += ce; st += (ce + 255) >> 8; } mtabs[32] = so; mtabs[33 + 32] = st; }
        __syncthreads();
    }
    if (IN(9)) {
        REFRESH();
        _Pragma("unroll 1") for (int rep_ = 0; rep_ < REPS(9); ++rep_) {
        pg8::MoeOrder S{mtabs, (const int*)(ws + WS_CTL + CTL_CNT), (const int*)(ws + WS_ELIST), 4, DM, F.G, (int)blockIdx.x, 1, (size_t)1024 * DM};
        pg8::EpiAct E{(unsigned char*)(ws + WS_ATT)};
        pg8::gemm_phase<pg8::EpiAct, pg8::MoeOrder, true>(F.lds + RING_OFF, Hb, W13t, DM, S, E);
        if (rep_ == 0) {
            __syncthreads();
            LAS float* scr = (LAS float*)(F.lds + RING_OFF + F.wave * 8704);
            unsigned* qctr = (unsigned*)(ws + WS_CTL + CTL_CNT) + 64;
            constexpr int I_E2 = (DE / 64) * (DM / 32), NQ = NE * I_E2;
            for (;;) {
                int it0 = 0; if (F.lane == 0) it0 = (int)__hip_atomic_fetch_add(qctr, 16u, __ATOMIC_RELAXED, __HIP_MEMORY_SCOPE_AGENT);
                it0 = __builtin_amdgcn_readfirstlane(it0);
                if (it0 >= NQ) break;
#define W2_DECODE(d, it) do { const int e = (it) / I_E2, r = (it) - e * I_E2, nblk = DM / 32, kb = r / nblk, nb = r % nblk; \
                    d = TrItem{w2 + (size_t)e * DE * DM, (unsigned char*)W2t + (size_t)e * DM * DE, DM, 64 * kb, 32 * nb, DE, (long)(32 * nb), W2_SCALE}; } while (0)
                TR_STREAM(W2_DECODE, it0, 1, it0 + 16);
#undef W2_DECODE
            }
        }
        }
        if (BOTH(9)) GRID_BAR();
    }
    if (IN(10)) {
        REFRESH();
        pg8::MoeOrder S{mtabs, (const int*)(ws + WS_CTL + CTL_CNT), (const int*)(ws + WS_ELIST), 8, DE, F.G, (int)blockIdx.x, 0, (size_t)DM * DE};
        pg8::EpiY E{(unsigned char*)(ws + WS_PROJ), (const float*)(ws + WS_ELISTW)};
        pg8::gemm_phase<pg8::EpiY, pg8::MoeOrder, true>(F.lds + RING_OFF, (const void*)(ws + WS_ATT), W2t, DE, S, E);
#if PROBE_PHASE == 10
        {
        pg8::MoeOrder S{mtabs, (const int*)(ws + WS_CTL + CTL_CNT), (const int*)(ws + WS_ELIST), 8, DE, F.G, (int)blockIdx.x, 0, (size_t)DM * DE};
        pg8::EpiY E{(unsigned char*)(ws + WS_PROJ), (const float*)(ws + WS_ELISTW)};
        pg8::gemm_phase<pg8::EpiY, pg8::MoeOrder, true>(F.lds + RING_OFF, (const void*)(ws + WS_ATT), W2t, DE, S, E);
        }
#endif
        if (BOTH(10)) GRID_BAR();
    }
    if (IN(11)) {
        REFRESH();
        const int* tokslot = (const int*)(ws + WS_TOKSLOT); const bf16_t* Y = (const bf16_t*)(ws + WS_PROJ); const float* nfw = args.in[16];
        float* outp = args.out;
        const int gw = blockIdx.x * NWAVES + F.wave, NGW = F.G * NWAVES;
        typedef int i32x2 __attribute__((ext_vector_type(2)));
        const i32x2* ts2 = (const i32x2*)tokslot;
        _Pragma("unroll 1") for (int rep_ = 0; rep_ < REPS(11); ++rep_) {
        constexpr int NR = 4;
        i32x2 ts[NR];
#pragma unroll
        for (int r = 0; r < NR; ++r) ts[r] = ts2[gw + r * NGW < MTOK ? gw + r * NGW : 0];
#pragma unroll 1
        for (int row = gw; row < MTOK; row += NR * NGW) {
            u32x4 xw[NR][4]; u32x2 ya[NR][4], yc[NR][4];
#pragma unroll
            for (int r = 0; r < NR; ++r) { const int rw = row + r * NGW < MTOK ? row + r * NGW : row;
                const size_t p0 = (size_t)(mtabs[ts[r].x >> 16] + (ts[r].x & 0xffff)), p1 = (size_t)(mtabs[ts[r].y >> 16] + (ts[r].y & 0xffff));
                const u32x4* xr = (const u32x4*)((const bf16_t*)(ws + WS_X1) + (size_t)rw * DM) + F.lane;
                const u32x2* y0 = (const u32x2*)((const unsigned char*)Y + p0 * DM) + F.lane; const u32x2* y1 = (const u32x2*)((const unsigned char*)Y + p1 * DM) + F.lane;
#pragma unroll
                for (int j = 0; j < 4; ++j) { xw[r][j] = xr[64 * j]; ya[r][j] = y0[64 * j]; yc[r][j] = y1[64 * j]; } }
#pragma unroll
            for (int r = 0; r < NR; ++r) { const int nr = row + (NR + r) * NGW; ts[r] = ts2[nr < MTOK ? nr : row]; }
#pragma unroll
            for (int r = 0; r < NR; ++r) { const bool vr = row + r * NGW < MTOK; const int rw = vr ? row + r * NGW : row; const int b = rw / SEQ;
                const f32x4* gf = (const f32x4*)(mod + (size_t)b * NMOD + 5 * DM) + 2 * F.lane;
                f32x4 v[8]; float s = 0.f;
#pragma unroll
                for (int j = 0; j < 4; ++j) { const u32x4 xv = xw[r][j]; const u32x2 a = ya[r][j], c = yc[r][j]; const f32x4 g0 = gf[128 * j], g1 = gf[128 * j + 1];
#define BL(w) __uint_as_float((w) << 16)
#define BH(w) __uint_as_float((w) & 0xffff0000u)
                    const f32x4 x0 = {BL(xv.x), BH(xv.x), BL(xv.y), BH(xv.y)}, x1v = {BL(xv.z), BH(xv.z), BL(xv.w), BH(xv.w)};
#undef BL
#undef BH
                    const auto a0 = __builtin_amdgcn_cvt_pk_f32_fp8((int)a.x, false), a1 = __builtin_amdgcn_cvt_pk_f32_fp8((int)a.x, true), a2 = __builtin_amdgcn_cvt_pk_f32_fp8((int)a.y, false), a3 = __builtin_amdgcn_cvt_pk_f32_fp8((int)a.y, true);
                    const auto c0 = __builtin_amdgcn_cvt_pk_f32_fp8((int)c.x, false), c1 = __builtin_amdgcn_cvt_pk_f32_fp8((int)c.x, true), c2 = __builtin_amdgcn_cvt_pk_f32_fp8((int)c.y, false), c3 = __builtin_amdgcn_cvt_pk_f32_fp8((int)c.y, true);
                    const f32x4 yA = {a0[0] + c0[0], a0[1] + c0[1], a1[0] + c1[0], a1[1] + c1[1]}, yB = {a2[0] + c2[0], a2[1] + c2[1], a3[0] + c3[0], a3[1] + c3[1]};
                    v[2 * j] = x0 + g0 * yA; v[2 * j + 1] = x1v + g1 * yB;
                    s += (v[2 * j].x * v[2 * j].x + v[2 * j].y * v[2 * j].y) + (v[2 * j].z * v[2 * j].z + v[2 * j].w * v[2 * j].w);
                    s += (v[2 * j + 1].x * v[2 * j + 1].x + v[2 * j + 1].y * v[2 * j + 1].y) + (v[2 * j + 1].z * v[2 * j + 1].z + v[2 * j + 1].w * v[2 * j + 1].w); }
                const float rstd = rsqrtf(wave_sum(s) * (1.f / DM) + EPS);
                if (vr) { f32x4* orow = (f32x4*)(outp + (size_t)rw * DM) + 2 * F.lane;
#pragma unroll
                    for (int j = 0; j < 4; ++j) { const f32x4 w0 = *((const f32x4*)nfw + 2 * F.lane + 128 * j), w1 = *((const f32x4*)nfw + 2 * F.lane + 128 * j + 1);
                        orow[128 * j] = v[2 * j] * rstd * w0; orow[128 * j + 1] = v[2 * j + 1] * rstd * w1; } } }
        }
        }
    }
#if defined(PROBE_EXTRA_BARS)
    for (int i = 0; i < PROBE_EXTRA_BARS; ++i) GRID_BAR();
#endif
#undef IN
#undef BOTH
#undef GRID_BAR
}

extern "C" void kernel_launch(void* const* d_in, const int* in_sizes, int n_in, void* d_out, int out_size, void* d_ws, size_t ws_size, hipStream_t stream) {
  static int grid = 0;
  if (grid == 0) {
    if (ws_size < WS_END || n_in != 17) { fprintf(stderr, "kernel_launch: ws too small (%zu < %zu) or n_in %d\n", ws_size, (size_t)WS_END, n_in); grid = -1; return; }
    int dev = 0, cus = 0, per_cu = 0;
    if (hipGetDevice(&dev) != hipSuccess || hipDeviceGetAttribute(&cus, hipDeviceAttributeMultiprocessorCount, dev) != hipSuccess) { grid = -1; return; }
    if (hipFuncSetAttribute((const void*)mk_fwd, hipFuncAttributeMaxDynamicSharedMemorySize, LDS_BYTES) != hipSuccess) { fprintf(stderr, "kernel_launch: hipFuncSetAttribute failed\n"); grid = -1; return; }
    if (hipOccupancyMaxActiveBlocksPerMultiprocessor(&per_cu, (const void*)mk_fwd, NTHR, LDS_BYTES) != hipSuccess || per_cu < 1) { fprintf(stderr, "kernel_launch: occupancy query says %d blocks/CU\n", per_cu); grid = -1; (void)hipGetLastError(); return; }
    grid = cus;
    fprintf(stderr, "kernel_launch: grid %d, occupancy %d/CU, ws %zu\n", grid, per_cu, ws_size);
  }
  if (grid < 0) return;
  char* ws = (char*)d_ws; float* out = (float*)d_out;
  hipMemsetAsync(ws + WS_CTL, 0, CTL_ZERO_BYTES, stream);
  Args a{};
  for (int i = 0; i < 17; ++i) a.in[i] = (const float*)d_in[i];
  a.out = out; a.ws = (unsigned char*)d_ws;
  a.ph_lo = 0; a.ph_hi = 12; a.li = 0;
  hipLaunchKernelGGL(mk_fwd, dim3(grid), dim3(NTHR), LDS_BYTES, stream, a);
}
```

```cpp
#include <hip/hip_runtime.h>
#include <hip/hip_bf16.h>
#include <cstdio>
#include <cstdint>

constexpr int DM = 2048, NB = 4, SEQ = 4096, MTOK = NB * SEQ;
constexpr int AH = 8, AD = 128, AW = 1024;
constexpr int RH = 4, RD = 256, RW = 1024;
constexpr int INW = 7168;
constexpr int NE = 32, DE = 512;
constexpr int NMOD = 6 * DM;
constexpr int C_QA = 0, C_KA = 1024, C_VA = 2048, C_QR = 3072, C_KR = 4096, C_VR = 5120, C_GR = 6144;
constexpr float EPS = 1e-6f;
constexpr int LCAP = 16384;

typedef unsigned short bf16_t;
#define LAS __attribute__((address_space(3)))
#define GAS __attribute__((address_space(1)))
typedef short bf16x8 __attribute__((ext_vector_type(8)));
typedef float f32x4 __attribute__((ext_vector_type(4)));
typedef unsigned u32x4 __attribute__((ext_vector_type(4)));
typedef unsigned u32x2 __attribute__((ext_vector_type(2)));

__device__ __forceinline__ float bf2f(bf16_t v) { return __uint_as_float((unsigned)v << 16); }
__device__ __forceinline__ unsigned f2bf(float f) { unsigned u = __float_as_uint(f); return (u + 0x7fffu + ((u >> 16) & 1u)) >> 16; }
__device__ __forceinline__ unsigned pk2(float lo, float hi) { return f2bf(lo) | (f2bf(hi) << 16); }
__device__ __forceinline__ float ldf(const float* p) { return *p; }
__device__ __forceinline__ float ldf(const bf16_t* p) { return bf2f(*p); }
__device__ __forceinline__ void stf(float* p, float v) { *p = v; }
__device__ __forceinline__ void stf(bf16_t* p, float v) { *p = (bf16_t)f2bf(v); }
__device__ __forceinline__ float silu_f(float v) { return v / (1.f + __expf(-v)); }
__device__ __forceinline__ unsigned cvt4_fp8(float a, float b, float c, float d) { int w = __builtin_amdgcn_cvt_pk_fp8_f32(a, b, 0, false); w = __builtin_amdgcn_cvt_pk_fp8_f32(c, d, w, true); return (unsigned)w; }
typedef int i32x8 __attribute__((ext_vector_type(8)));
typedef int i32x4 __attribute__((ext_vector_type(4)));
constexpr float W13_SCALE = 64.f, W2_SCALE = 32.f;

constexpr size_t MiB = 1u << 20;
constexpr size_t WS_CTL = 0, CTL_ZERO_BYTES = 1 * MiB;
constexpr size_t CTL_BAR = 0;
constexpr size_t CTL_CNT = 256 * 1024;
constexpr size_t CTL_KMEAN = 512 * 1024;
constexpr size_t WS_MODP = 1 * MiB;
constexpr size_t WS_MOD = 4 * MiB;
constexpr size_t WS_ELIST = 5 * MiB;
constexpr size_t WS_ELISTW = 7 * MiB;
constexpr size_t WS_TOKSLOT = 9 * MiB;
constexpr size_t WS_EID = 9 * MiB + 256 * 1024;
constexpr size_t WS_EWT = 9 * MiB + 512 * 1024;
constexpr size_t WS_WR = 10 * MiB;
constexpr size_t WS_WIN = 12 * MiB;
constexpr size_t WS_WOUT = 40 * MiB;
constexpr size_t WS_W13 = 48 * MiB;
constexpr size_t WS_W2 = 176 * MiB;
constexpr size_t WS_H = 240 * MiB;
constexpr size_t WS_ATT = 304 * MiB;
constexpr size_t WS_PROJ = 368 * MiB;
constexpr size_t WS_X1 = WS_PROJ + 128 * MiB;
constexpr size_t WS_END = 592 * MiB;

#ifndef PROBE_PHASE
#define PROBE_PHASE -1
#endif
#ifndef PROBE_STOP
#define PROBE_STOP 0
#endif
#ifndef PROBE_REPS
#define PROBE_REPS 1
#endif
constexpr int NWAVES = 8, NTHR = 512;
constexpr int RING_OFF = 0, RING_BYTES = 131072;
constexpr int LDSCTL_OFF = RING_BYTES, MISC_OFF = LDSCTL_OFF + 320;
constexpr int LDS_BYTES = 147456;

typedef GAS unsigned gu32;
#define RLX_AGENT __ATOMIC_RELAXED, __HIP_MEMORY_SCOPE_AGENT
#define LDS_WAIT() asm volatile("s_waitcnt lgkmcnt(0)" ::: "memory")
#define VM_WAIT() asm volatile("s_waitcnt vmcnt(0)" ::: "memory")

#define XB_TMO      128
#define XB_XCNT(j)  (256  + 64 * (j))
#define XB_XSUB(j)  (1280 + 64 * (j))
#define XB_XGEN(j)  (2304 + 64 * (j))
#define XB_TOP      3328
#define XB_TOPGEN   3392
#define XCD_BAR_WORDS 3456
#define XB_SPIN_CAP (1u << 18)
__device__ __forceinline__ unsigned xb_ld(unsigned* p)              { return __hip_atomic_load(p, __ATOMIC_RELAXED, __HIP_MEMORY_SCOPE_AGENT); }
__device__ __forceinline__ unsigned xb_add(unsigned* p, unsigned v) { return __hip_atomic_fetch_add(p, v, __ATOMIC_RELAXED, __HIP_MEMORY_SCOPE_AGENT); }
__device__ __forceinline__ unsigned xb_xcc_id() { return (unsigned)__builtin_amdgcn_s_getreg((3 << 11) | 20) & 0xFu; }
#define XB_SPIN(cond, bar) do { unsigned _sp = 0; while (cond) { __builtin_amdgcn_s_sleep(1); \
    if ((++_sp & 255u) == 0u) { if (xb_ld(&(bar)[XB_TMO])) break; if (_sp > XB_SPIN_CAP) { atomicAdd(&(bar)[XB_TMO], 1u); break; } } } } while (0)
struct XcdBarrier { unsigned* bar; unsigned x; volatile LAS unsigned* st; };
__device__ __forceinline__ XcdBarrier xcd_barrier_post(unsigned* bar, volatile LAS unsigned* st) {
    XcdBarrier b; b.bar = bar; b.x = xb_xcc_id(); b.st = st;
    if (threadIdx.x == 0) (void)xb_add(&bar[XB_XCNT(b.x)], 1u);
    return b;
}
__device__ __forceinline__ void xcd_barrier_complete(unsigned* bar, unsigned x, unsigned& nloc, unsigned& nx) {
    const unsigned G = gridDim.x * gridDim.y * gridDim.z;
    unsigned sum, cnt, mine, sp = 0u;
    for (;;) {
        sum = 0u; cnt = 0u; mine = 0u;
#pragma unroll
        for (unsigned j = 0; j < 16; ++j) { const unsigned c = xb_ld(&bar[XB_XCNT(j)]); sum += c; cnt += (c > 0u) ? 1u : 0u; mine = (j == x) ? c : mine; }
        if (sum == G) break;
        __builtin_amdgcn_s_sleep(1);
        if ((++sp & 255u) == 0u) { if (xb_ld(&bar[XB_TMO])) break; if (sp > XB_SPIN_CAP) { atomicAdd(&bar[XB_TMO], 1u); break; } }
    }
    nloc = mine > 0u ? mine : 1u; nx = cnt > 0u ? cnt : 1u;
}
__device__ __forceinline__ void xcd_barrier(const XcdBarrier& b) {
    asm volatile("s_waitcnt vmcnt(0)" ::: "memory");
    __syncthreads();
    if (threadIdx.x == 0) {
        unsigned* bar = b.bar;
        __builtin_amdgcn_s_waitcnt(0);
        unsigned nloc = b.st[0], nx = b.st[1];
        if (nloc == 0u) { xcd_barrier_complete(bar, b.x, nloc, nx); b.st[0] = nloc; b.st[1] = nx; }
        const unsigned old = xb_add(&bar[XB_XSUB(b.x)], 1u);
        const unsigned gen = old / nloc;
        if (old + 1u == (gen + 1u) * nloc) {
            __builtin_amdgcn_fence(__ATOMIC_RELEASE, "agent");
            asm volatile("s_waitcnt vmcnt(0)" ::: "memory");
            const unsigned og = xb_add(&bar[XB_TOP], 1u);
            const unsigned tg = og / nx;
            if (og + 1u == (tg + 1u) * nx) xb_add(&bar[XB_TOPGEN], 1u);
            else XB_SPIN(xb_ld(&bar[XB_TOPGEN]) == tg, bar);
            xb_add(&bar[XB_XGEN(b.x)], 1u);
            __builtin_amdgcn_fence(__ATOMIC_ACQUIRE, "agent");
            asm volatile("s_waitcnt vmcnt(0)" ::: "memory");
        } else {
            XB_SPIN(xb_ld(&bar[XB_XGEN(b.x)]) == gen, bar);
            __builtin_amdgcn_fence(__ATOMIC_ACQUIRE, "agent");
            asm volatile("s_waitcnt vmcnt(0)" ::: "memory");
        }
    }
    __syncthreads();
}

__device__ __forceinline__ void xcd_arrive(const XcdBarrier& b, unsigned* bar2) {
    asm volatile("s_waitcnt vmcnt(0)" ::: "memory");
    __syncthreads();
    if (threadIdx.x == 0) {
        unsigned nloc = b.st[0], nx = b.st[1];
        if (nloc == 0u) { xcd_barrier_complete(b.bar, b.x, nloc, nx); b.st[0] = nloc; b.st[1] = nx; }
        const unsigned old = xb_add(&bar2[XB_XSUB(b.x)], 1u);
        if (old + 1u == nloc) { __builtin_amdgcn_fence(__ATOMIC_RELEASE, "agent"); asm volatile("s_waitcnt vmcnt(0)" ::: "memory"); xb_add(&bar2[XB_TOP], 1u); }
    }
}
__device__ __forceinline__ void xcd_wait(const XcdBarrier& b, unsigned* bar2) {
    __syncthreads();
    if (threadIdx.x == 0) {
        const unsigned nx = b.st[1]; unsigned sp = 0u;
        while (xb_ld(&bar2[XB_TOP]) < nx) { __builtin_amdgcn_s_sleep(2); if (++sp > (1u << 22)) { atomicAdd(&b.bar[XB_TMO], 1u); break; } }
        __builtin_amdgcn_fence(__ATOMIC_ACQUIRE, "agent");
        asm volatile("s_waitcnt vmcnt(0)" ::: "memory");
    }
    __syncthreads();
}

namespace pg8 {
constexpr int BM = 256, BK = 64, HALF = 128, HTB = HALF * BK * 2, STAGE_BYTES = 8 * HTB, NXCD = 8, WGM = 2;
__host__ __device__ __forceinline__ int lds_byte(int r, int c) { const int st = (r >> 4) * 2 + (c >> 5), rr = r & 15, cc = c & 31, ob = rr * 64 + cc * 2; return st * 1024 + (ob ^ (((ob >> 9) & 1) << 5)); }
__host__ __device__ __forceinline__ void stage_rc(int b, int& R, int& C) { const int st = b / 1024, sb = b % 1024, swz = sb ^ (((sb >> 9) & 1) << 5); R = (st >> 1) * 16 + swz / 64; C = (st & 1) * 32 + (swz % 64) / 2; }
__host__ __device__ __forceinline__ int perm32(int rho) { const int n = rho >> 4, i = rho & 15; return 8 * (i >> 2) + 4 * n + (i & 3); }
struct Unit { int pm, pn, e, nrows, row0; };
typedef __bf16 bf16x2n __attribute__((ext_vector_type(2)));
typedef float f32x2n __attribute__((ext_vector_type(2)));
__device__ __forceinline__ unsigned cvt_pk_bf16(float lo, float hi) { const f32x2n v = {lo, hi}; return __builtin_bit_cast(unsigned, __builtin_convertvector(v, bf16x2n)); }

struct DenseOrder {
    int nM, nN, nwg, G, c, K;
    __device__ void init(int M, int N, int K_, int G_, int c_) { nM = M / BM; nN = N / BM; nwg = nM * nN; G = G_; c = c_; K = K_; }
    __device__ __forceinline__ bool next(int i, Unit& u) const {
        const long L = (long)i * G + c; if (L >= nwg) return false;
        int wgid = (int)L;
        const int nig = WGM * nN, gid = wgid / nig, fm = gid * WGM, gsz = (nM - fm) < WGM ? (nM - fm) : WGM;
        u.pm = fm + ((wgid % nig) % gsz); u.pn = (wgid % nig) / gsz; u.e = 0; u.nrows = BM; u.row0 = u.pm * BM; return true;
    }
    __device__ __forceinline__ unsigned a_rowoff(const Unit& u, int r) const { return (unsigned)(u.pm * BM + r) * (unsigned)(K * 2); }
    __device__ __forceinline__ size_t b_off(const Unit& u) const { return (size_t)u.pn * BM * K * 2; }
};

template <class Epi, class Sched, bool FP8 = false>
__device__ __forceinline__ void gemm_phase(LAS unsigned char* lds, const void* Aptr, const void* Btptr, const int KB  , const Sched& S, const Epi& E) {
    const int tid = threadIdx.x, wid = __builtin_amdgcn_readfirstlane(tid >> 6), lane = tid & 63, wr = wid >> 2, wc = wid & 3, fr = lane & 15, fq = lane >> 4;
    const int nt = KB / (BK * 2);
    int sR[2], sC[2]; unsigned voffB[2];
#pragma unroll
    for (int i = 0; i < 2; ++i) { stage_rc(tid * 16 + i * 8192, sR[i], sC[i]); const int Rb = Epi::PERM ? ((sR[i] & ~31) + perm32(sR[i] & 31)) : sR[i]; voffB[i] = (unsigned)(Rb * KB + sC[i] * 2); }
    const size_t kstep = (size_t)(BK * 2);
    const size_t hstepB = (size_t)HALF * KB;
    const unsigned ldsw = (unsigned)wid * 1024u;
    const int aoff = lds_byte(wr * 64 + fr, fq * 8), boff = lds_byte(wc * 32 + fr, fq * 8);
    const char* Ab = (const char*)Aptr; const char* Bb = (const char*)Btptr;
#define PG8_SA(b, h) (((b) * 2 + (h)) * HTB)
#define PG8_SB(b, h) ((4 + (b) * 2 + (h)) * HTB)
#define PG8_STAGE_B(bufoff, gbase) do { _Pragma("unroll") for (int _i = 0; _i < 2; ++_i) \
        __builtin_amdgcn_global_load_lds((const unsigned*)((const char*)(gbase) + voffB[_i]), (LAS unsigned*)(lds + (bufoff) + ldsw + _i * 8192), 16, 0, 0); } while (0)
#define PG8_STAGE_A(bufoff, vo, h, kb) do { _Pragma("unroll") for (int _i = 0; _i < 2; ++_i) \
        __builtin_amdgcn_global_load_lds((const unsigned*)(Ab + (size_t)(vo)[h][_i] + (kb)), (LAS unsigned*)(lds + (bufoff) + ldsw + _i * 8192), 16, 0, 0); } while (0)
#define PG8_LD8(p) __builtin_shufflevector(*(const LAS i32x4*)(p), *(const LAS i32x4*)((p) + 1024), 0, 1, 2, 3, 4, 5, 6, 7)
#define PG8_LDA(dst, b, h) do { _Pragma("unroll") for (int m = 0; m < 4; ++m) { if constexpr (FP8) dst##8[m] = PG8_LD8(lds + PG8_SA(b, h) + aoff + m * 2048); \
        else { _Pragma("unroll") for (int k = 0; k < 2; ++k) dst[m][k] = *(const LAS bf16x8*)(lds + PG8_SA(b, h) + aoff + m * 2048 + k * 1024); } } } while (0)
#define PG8_LDB(dst, b, h) do { _Pragma("unroll") for (int n = 0; n < 2; ++n) { if constexpr (FP8) dst##8[n] = PG8_LD8(lds + PG8_SB(b, h) + boff + n * 2048); \
        else { _Pragma("unroll") for (int k = 0; k < 2; ++k) dst[n][k] = *(const LAS bf16x8*)(lds + PG8_SB(b, h) + boff + n * 2048 + k * 1024); } } } while (0)
#define PG8_MMA(ai, bj, At, Bt) do { __builtin_amdgcn_s_setprio(1); _Pragma("unroll") for (int m = 0; m < 4; ++m) _Pragma("unroll") for (int n = 0; n < 2; ++n) { \
        if constexpr (FP8) asm volatile("s_nop 1\n\tv_mfma_f32_16x16x128_f8f6f4 %0, %1, %2, %0" : "+v"(acc[ai][bj][m][n]) : "v"(Bt##8[n]), "v"(At##8[m])); \
        else { _Pragma("unroll") for (int k = 0; k < 2; ++k) acc[ai][bj][m][n] = __builtin_amdgcn_mfma_f32_16x16x32_bf16(Bt[n][k], At[m][k], acc[ai][bj][m][n], 0, 0, 0); } } __builtin_amdgcn_s_setprio(0); } while (0)
#define PG8_WAIT_V(n) asm volatile("s_waitcnt vmcnt(" #n ")" ::: "memory")
#define PG8_WAIT_L(n) asm volatile("s_waitcnt lgkmcnt(" #n ")" ::: "memory")
#define PG8_WAIT_V8X(tt) do { if constexpr (Epi::NVM > 0) asm volatile("s_waitcnt vmcnt(%1)\n\ts_cmp_eq_u32 %0, 0\n\ts_cbranch_scc1 1f\n\ts_waitcnt vmcnt(8)\n1:" :: "s"(tt), "n"(8 + Epi::NVM) : "memory", "scc"); \
        else PG8_WAIT_V(8); } while (0)
#define PG8_BAR __builtin_amdgcn_s_barrier()
#define PG8_SCHED __builtin_amdgcn_sched_barrier(0)
#define PG8_SETA(v, u) do { _Pragma("unroll") for (int _h = 0; _h < 2; ++_h) _Pragma("unroll") for (int _i = 0; _i < 2; ++_i) (v)[_h][_i] = S.a_rowoff((u), _h * HALF + sR[_i]) + (unsigned)(sC[_i] * 2); } while (0)
    Unit cur, nxt; int ui = 0;
    if (!S.next(0, cur)) return;
    f32x4 acc[2][2][4][2];
#pragma unroll
    for (int a = 0; a < 2; ++a)
#pragma unroll
        for (int b = 0; b < 2; ++b)
#pragma unroll
            for (int m = 0; m < 4; ++m)
#pragma unroll
                for (int n = 0; n < 2; ++n) acc[a][b][m][n] = (f32x4){0.f, 0.f, 0.f, 0.f};
    bf16x8 At[4][2], B0[2][2], B1[2][2]; i32x8 At8[4], B08[2], B18[2];
    unsigned cvA[2][2], nvA[2][2];
    PG8_SETA(cvA, cur);
    const char* cB = Bb + S.b_off(cur);
    PG8_STAGE_B(PG8_SB(0, 0), cB); PG8_STAGE_B(PG8_SB(0, 1), cB + hstepB); PG8_STAGE_A(PG8_SA(0, 0), cvA, 0, 0); PG8_STAGE_A(PG8_SA(0, 1), cvA, 1, 0);
    if (wr == 1) PG8_BAR;
    PG8_WAIT_V(2); PG8_BAR;
    PG8_STAGE_B(PG8_SB(1, 0), cB + kstep); PG8_STAGE_A(PG8_SA(1, 0), cvA, 0, kstep); PG8_STAGE_B(PG8_SB(1, 1), cB + hstepB + kstep);
    if constexpr (Epi::NVM > 0) PG8_WAIT_V(0); else PG8_WAIT_V(6);
    PG8_BAR;
    for (;;) {
        const bool has_next = S.next(ui + 1, nxt);
        const char* nB = cB;
        if (has_next) { PG8_SETA(nvA, nxt); nB = Bb + S.b_off(nxt); }
        else {
#pragma unroll
            for (int _h = 0; _h < 2; ++_h)
#pragma unroll
                for (int _i = 0; _i < 2; ++_i) nvA[_h][_i] = cvA[_h][_i];
        }
        for (int t = 0; t < nt; t += 2) {
            const bool last = (t == nt - 2);
            const size_t k1 = (size_t)(t + 1) * kstep;
            const size_t k2 = last ? (size_t)0 : (size_t)(t + 2) * kstep;
            const size_t k3 = k2 + kstep;
            unsigned xA[2][2];
#pragma unroll
            for (int _h = 0; _h < 2; ++_h)
#pragma unroll
                for (int _i = 0; _i < 2; ++_i) xA[_h][_i] = last ? nvA[_h][_i] : cvA[_h][_i];
            const char* b2 = (last ? nB : cB) + k2; const char* b3 = b2 + kstep;
            PG8_LDB(B0, 0, 0); PG8_LDB(B1, 0, 1); PG8_SCHED; PG8_LDA(At, 0, 0); PG8_STAGE_A(PG8_SA(1, 1), cvA, 1, k1);
            PG8_WAIT_V8X(t); PG8_WAIT_L(0); PG8_BAR; PG8_MMA(0, 0, At, B0); PG8_MMA(0, 1, At, B1); PG8_BAR; PG8_SCHED;
            PG8_LDA(At, 0, 1); PG8_STAGE_B(PG8_SB(0, 0), b2); PG8_STAGE_B(PG8_SB(0, 1), b2 + hstepB); PG8_STAGE_A(PG8_SA(0, 0), xA, 0, k2);
            PG8_WAIT_V8X(t); PG8_WAIT_L(0); PG8_BAR; PG8_MMA(1, 0, At, B0); PG8_MMA(1, 1, At, B1); PG8_BAR; PG8_SCHED;
            PG8_LDB(B0, 1, 0); PG8_LDB(B1, 1, 1); PG8_SCHED; PG8_LDA(At, 1, 0); PG8_STAGE_A(PG8_SA(0, 1), xA, 1, k2);
            PG8_WAIT_V(8); PG8_WAIT_L(0); PG8_BAR; PG8_MMA(0, 0, At, B0); PG8_MMA(0, 1, At, B1); PG8_BAR; PG8_SCHED;
            PG8_LDA(At, 1, 1); PG8_STAGE_B(PG8_SB(1, 0), b3); PG8_STAGE_B(PG8_SB(1, 1), b3 + hstepB); PG8_STAGE_A(PG8_SA(1, 0), xA, 0, k3);
            PG8_WAIT_V(8); PG8_WAIT_L(0); PG8_BAR; PG8_MMA(1, 0, At, B0); PG8_MMA(1, 1, At, B1); PG8_BAR; PG8_SCHED;
        }
        if constexpr (FP8) asm volatile("s_nop 15\n\ts_nop 15" ::: "memory");
        if (wr == 0) PG8_BAR;
        E(acc, cur, wr, wc, fr, fq);
        if (!has_next) break;
#pragma unroll
        for (int a = 0; a < 2; ++a)
#pragma unroll
            for (int b = 0; b < 2; ++b)
#pragma unroll
                for (int m = 0; m < 4; ++m)
#pragma unroll
                    for (int n = 0; n < 2; ++n) acc[a][b][m][n] = (f32x4){0.f, 0.f, 0.f, 0.f};
        cur = nxt; cB = nB; ++ui;
#pragma unroll
        for (int _h = 0; _h < 2; ++_h)
#pragma unroll
            for (int _i = 0; _i < 2; ++_i) cvA[_h][_i] = nvA[_h][_i];
        if (wr == 1) PG8_BAR;
    }
    PG8_WAIT_V(0);
    PG8_BAR;
#undef PG8_SA
#undef PG8_SB
#undef PG8_STAGE_A
#undef PG8_STAGE_B
#undef PG8_LDA
#undef PG8_LDB
#undef PG8_MMA
#undef PG8_LD8
#undef PG8_WAIT_V
#undef PG8_WAIT_V8X
#undef PG8_WAIT_L
#undef PG8_BAR
#undef PG8_SCHED
#undef PG8_SETA
}

struct EpiProj {
    static constexpr bool PERM = true; static constexpr int NVM = 16;
    bf16_t* O; float* kmean; int* kn2;
    __device__ __forceinline__ void operator()(const f32x4 (&acc)[2][2][4][2], const Unit& u, int wr, int wc, int fr, int fq) const {
        const int row0 = u.pm * BM + wr * 64 + fr, col0 = u.pn * BM + wc * 32 + 8 * fq;
#pragma unroll
        for (int ai = 0; ai < 2; ++ai)
#pragma unroll
            for (int m = 0; m < 4; ++m) { bf16_t* rowp = O + (size_t)(row0 + ai * HALF + m * 16) * INW + col0;
#pragma unroll
                for (int bj = 0; bj < 2; ++bj) { const f32x4 v0 = acc[ai][bj][m][0], v1 = acc[ai][bj][m][1];
                    u32x4 w; w.x = cvt_pk_bf16(v0[0], v0[1]); w.y = cvt_pk_bf16(v0[2], v0[3]); w.z = cvt_pk_bf16(v1[0], v1[1]); w.w = cvt_pk_bf16(v1[2], v1[3]);
                    *(u32x4*)(rowp + bj * HALF) = w; } }
        if (kmean && u.pn >= 4 && u.pn < 8) {
            const int b = u.pm >> 4, blk = u.pm & 15;
#pragma unroll
            for (int bj = 0; bj < 2; ++bj) { float sv[8];
#pragma unroll
                for (int n = 0; n < 2; ++n) {
                    f32x4 s = (f32x4){0.f, 0.f, 0.f, 0.f};
#pragma unroll
                    for (int ai = 0; ai < 2; ++ai)
#pragma unroll
                        for (int m = 0; m < 4; ++m) s += acc[ai][bj][m][n];
#pragma unroll
                    for (int j = 0; j < 4; ++j) { float v = s[j]; v += __shfl_xor(v, 1); v += __shfl_xor(v, 2); v += __shfl_xor(v, 4); v += __shfl_xor(v, 8); sv[4 * n + j] = v; } }
                float pick = sv[0];
#pragma unroll
                for (int k = 1; k < 8; ++k) pick = (fr & 7) == k ? sv[k] : pick;
                if (fr < 8) { const int col = (u.pn - 4) * BM + bj * HALF + wc * 32 + 8 * fq + fr; const int h = col >> 7, d = col & 127;
                    atomicAdd(kmean + ((b * AH + h) * 16 + blk) * AD + d, pick * (1.f / 256.f)); } }
#pragma unroll
            for (int bj = 0; bj < 2; ++bj) { float mx = 0.f;
#pragma unroll
                for (int ai = 0; ai < 2; ++ai)
#pragma unroll
                    for (int m = 0; m < 4; ++m) { const f32x4 a0 = acc[ai][bj][m][0], a1 = acc[ai][bj][m][1];
                        float q = ((a0[0] * a0[0] + a0[1] * a0[1]) + (a0[2] * a0[2] + a0[3] * a0[3])) + ((a1[0] * a1[0] + a1[1] * a1[1]) + (a1[2] * a1[2] + a1[3] * a1[3]));
                        q += __shfl_xor(q, 16); q += __shfl_xor(q, 32); mx = fmaxf(mx, q); }
                mx = fmaxf(mx, __shfl_xor(mx, 1)); mx = fmaxf(mx, __shfl_xor(mx, 2)); mx = fmaxf(mx, __shfl_xor(mx, 4)); mx = fmaxf(mx, __shfl_xor(mx, 8));
                if (fr == 0 && fq == 0) atomicMax(kn2 + ((b * AH + (u.pn - 4) * 2 + bj) * 16 + blk) * 4 + wc, __float_as_int(mx)); }
        }
    }
};

struct EpiOut {
    static constexpr bool PERM = true; static constexpr int NVM = 0;
    const float* x; const float* mod; bf16_t* out; float* rowss;
    __device__ __forceinline__ void operator()(const f32x4 (&acc)[2][2][4][2], const Unit& u, int wr, int wc, int fr, int fq) const {
        const int row0 = u.pm * BM + wr * 64 + fr, col0 = u.pn * BM + wc * 32 + 8 * fq, b = u.pm >> 4;
        f32x4 g[2][2];
#pragma unroll
        for (int bj = 0; bj < 2; ++bj)
#pragma unroll
            for (int n = 0; n < 2; ++n) g[bj][n] = *(const f32x4*)(mod + (size_t)b * NMOD + 2 * DM + col0 + bj * HALF + n * 4);
#pragma unroll
        for (int ai = 0; ai < 2; ++ai)
#pragma unroll
            for (int m = 0; m < 4; ++m) { const size_t off = (size_t)(row0 + ai * HALF + m * 16) * DM + col0; float ss = 0.f;
#pragma unroll
                for (int bj = 0; bj < 2; ++bj) { const f32x4 x0 = *(const f32x4*)(x + off + bj * HALF), x1v = *(const f32x4*)(x + off + bj * HALF + 4);
                    const f32x4 v0 = x0 + g[bj][0] * acc[ai][bj][m][0], v1 = x1v + g[bj][1] * acc[ai][bj][m][1];
                    ss += ((v0[0] * v0[0] + v0[1] * v0[1]) + (v0[2] * v0[2] + v0[3] * v0[3])) + ((v1[0] * v1[0] + v1[1] * v1[1]) + (v1[2] * v1[2] + v1[3] * v1[3]));
                    u32x4 w; w.x = cvt_pk_bf16(v0[0], v0[1]); w.y = cvt_pk_bf16(v0[2], v0[3]); w.z = cvt_pk_bf16(v1[0], v1[1]); w.w = cvt_pk_bf16(v1[2], v1[3]);
                    *(u32x4*)(out + off + bj * HALF) = w; }
                ss += __shfl_xor(ss, 16); ss += __shfl_xor(ss, 32);
                if (fq == 0) rowss[(size_t)(u.pn * 4 + wc) * MTOK + row0 + ai * HALF + m * 16] = ss; }
    }
};

struct MoeOrder {
    const LAS int* tabs; const int* cnt; const int* elist; int npn, K, G, c, gather; size_t bstride;
    __device__ __forceinline__ bool next(int i, Unit& u) const {
        const int L = i * G + c, RT = __builtin_amdgcn_readfirstlane(tabs[33 + 32]);
        if (L >= RT * npn) return false;
        const int rt = L / npn; u.pn = L - rt * npn;
        int e = 0;
        for (int j = 1; j < NE; ++j) if (tabs[33 + j] <= rt) e = j;
        e = __builtin_amdgcn_readfirstlane(e);
        u.e = e; u.pm = __builtin_amdgcn_readfirstlane(rt - tabs[33 + e]); u.pn = __builtin_amdgcn_readfirstlane(u.pn);
        const int ce = __builtin_amdgcn_readfirstlane(tabs[e + 1] - tabs[e]);
        u.nrows = min(BM, ce - u.pm * BM); u.row0 = __builtin_amdgcn_readfirstlane(tabs[e]) + u.pm * BM; return true;
    }
    __device__ __forceinline__ unsigned a_rowoff(const Unit& u, int r) const {
        if (gather) { const int idx = (r < u.nrows) ? u.pm * BM + r : u.pm * BM; return (unsigned)(elist[u.e * LCAP + idx] >> 1) * (unsigned)K; }
        const int row = min(u.row0 + r, 2 * MTOK - 1); return (unsigned)row * (unsigned)K;
    }
    __device__ __forceinline__ size_t b_off(const Unit& u) const { return (size_t)u.e * bstride + (size_t)u.pn * BM * K; }
};
__device__ __forceinline__ float silu_fast(float v) { return v * __builtin_amdgcn_rcpf(1.f + __expf(-v)); }
struct EpiAct {
    static constexpr bool PERM = true; static constexpr int NVM = 0;
    unsigned char* O;
    __device__ __forceinline__ void operator()(const f32x4 (&acc)[2][2][4][2], const Unit& u, int wr, int wc, int fr, int fq) const {
        const int col0 = u.pn * HALF + wc * 32 + 8 * fq; constexpr float IS = 1.f / W13_SCALE;
#pragma unroll
        for (int ai = 0; ai < 2; ++ai)
#pragma unroll
            for (int m = 0; m < 4; ++m) { const int rl = ai * HALF + wr * 64 + m * 16 + fr;
                if (rl < u.nrows) { const f32x4 a0 = acc[ai][0][m][0] * IS, a1 = acc[ai][0][m][1] * IS, b0 = acc[ai][1][m][0] * IS, b1 = acc[ai][1][m][1] * IS;
                    u32x2 w; w.x = cvt4_fp8(silu_fast(a0[0]) * b0[0], silu_fast(a0[1]) * b0[1], silu_fast(a0[2]) * b0[2], silu_fast(a0[3]) * b0[3]);
                    w.y = cvt4_fp8(silu_fast(a1[0]) * b1[0], silu_fast(a1[1]) * b1[1], silu_fast(a1[2]) * b1[2], silu_fast(a1[3]) * b1[3]);
                    *(u32x2*)(O + (size_t)(u.row0 + rl) * DE + col0) = w; } }
    }
};
struct EpiY {
    static constexpr bool PERM = true; static constexpr int NVM = 0;
    unsigned char* O; const float* elistw;
    __device__ __forceinline__ void operator()(const f32x4 (&acc)[2][2][4][2], const Unit& u, int wr, int wc, int fr, int fq) const {
        const int colw = u.pn * BM + wc * 32 + 16 * (fq >> 1);
        float rwv[2][4];
#pragma unroll
        for (int ai = 0; ai < 2; ++ai)
#pragma unroll
            for (int m = 0; m < 4; ++m) { const int rl = ai * HALF + wr * 64 + m * 16 + fr; rwv[ai][m] = elistw[u.e * LCAP + u.pm * BM + (rl < u.nrows ? rl : 0)] * (1.f / W2_SCALE); }
#pragma unroll
        for (int ai = 0; ai < 2; ++ai)
#pragma unroll
            for (int mp = 0; mp < 4; mp += 2) { const int rl = ai * HALF + wr * 64 + (mp + (fq & 1)) * 16 + fr;
                unsigned char* rowp = O + (size_t)(u.row0 + rl) * DM + colw;
#pragma unroll
                for (int bj = 0; bj < 2; ++bj) { const float r0 = rwv[ai][mp], r1 = rwv[ai][mp + 1];
                    const f32x4 v00 = acc[ai][bj][mp][0] * r0, v01 = acc[ai][bj][mp][1] * r0, v10 = acc[ai][bj][mp + 1][0] * r1, v11 = acc[ai][bj][mp + 1][1] * r1;
                    const unsigned w0x = cvt4_fp8(v00[0], v00[1], v00[2], v00[3]), w0y = cvt4_fp8(v01[0], v01[1], v01[2], v01[3]);
                    const unsigned w1x = cvt4_fp8(v10[0], v10[1], v10[2], v10[3]), w1y = cvt4_fp8(v11[0], v11[1], v11[2], v11[3]);
                    const auto rx = __builtin_amdgcn_permlane16_swap(w0x, w1x, false, false), ry = __builtin_amdgcn_permlane16_swap(w0y, w1y, false, false);
                    if (rl < u.nrows) *(u32x4*)(rowp + bj * HALF) = (u32x4){rx[0], ry[0], rx[1], ry[1]}; } }
    }
};
}


#ifndef MB_SDEPTH
#define MB_SDEPTH 2
#endif
namespace mb {
using s16x4  = __attribute__((ext_vector_type(4))) short;
using f32x16 = __attribute__((ext_vector_type(16))) float;
constexpr int D = 128, NW = 8, QBLK = 32, KVBLK = 64;
constexpr float SCALE = 0.088388347648318440f;
constexpr float THR = 8.f;
constexpr size_t SHM_V = KVBLK * D * 2, SHM_K = KVBLK * D * 2;
constexpr size_t OFF_WS = 2 * SHM_V + 2 * SHM_K, OFF_KM = OFF_WS + NW * 64 * 4;
constexpr size_t LDS_NEED = OFF_KM + 16 * 128 * 4 + 128;
constexpr float NEG = -1e30f;
#define KSWZ(row, colB) ((row) * 256 + ((colB) ^ (((row) & 7) << 4)))
#define SBAR() __builtin_amdgcn_sched_barrier(0)
__device__ __forceinline__ int crow(int r, int hi) { return (r & 3) + 8 * (r >> 2) + 4 * hi; }
__device__ __forceinline__ unsigned cvtpk(float lo, float hi) { return pg8::cvt_pk_bf16(lo, hi); }
__device__ __forceinline__ void partialSM(f32x16& p0, f32x16& p1, float& m_reg, float& mn, float& alpha) {
  constexpr float C = SCALE * 1.4426950408889634f;
  float pmax = p0[0];
#pragma unroll
  for (int r = 1; r < 16; ++r) pmax = fmaxf(pmax, p0[r]);
#pragma unroll
  for (int r = 0; r < 16; ++r) pmax = fmaxf(pmax, p1[r]);
  { auto rr = __builtin_amdgcn_permlane32_swap(__float_as_uint(pmax), __float_as_uint(pmax), false, false);
    pmax = fmaxf(__uint_as_float(rr[0]), __uint_as_float(rr[1])); }
  if (__builtin_expect(__all(pmax - m_reg <= THR / SCALE), 1)) { mn = m_reg; alpha = 1.f; }
  else { mn = fmaxf(m_reg, pmax); alpha = __builtin_amdgcn_exp2f((m_reg - mn) * C); m_reg = mn; }
  float mnC = -mn * C;
#pragma unroll
  for (int r = 0; r < 16; ++r) p0[r] = fmaf(p0[r], C, mnC);
#pragma unroll
  for (int r = 0; r < 16; ++r) p1[r] = fmaf(p1[r], C, mnC);
#pragma unroll
  for (int r = 0; r < 16; ++r) p0[r] = __builtin_amdgcn_exp2f(p0[r]);
}
__device__ __forceinline__ void finishSM(f32x16& p0, f32x16& p1, float alpha, float& l_reg, bf16x8& pa0, bf16x8& pa1, bf16x8& pa2, bf16x8& pa3) {
#pragma unroll
  for (int r = 0; r < 16; ++r) p1[r] = __builtin_amdgcn_exp2f(p1[r]);
  float ps = 0;
#pragma unroll
  for (int r = 0; r < 16; ++r) ps += p0[r];
#pragma unroll
  for (int r = 0; r < 16; ++r) ps += p1[r];
  { auto rr = __builtin_amdgcn_permlane32_swap(__float_as_uint(ps), __float_as_uint(ps), false, false);
    ps = __uint_as_float(rr[0]) + __uint_as_float(rr[1]); }
  l_reg = l_reg * alpha + ps;
#define PK4(P, BASE, OUT) do { unsigned a0 = cvtpk(P[BASE + 0], P[BASE + 1]), a1 = cvtpk(P[BASE + 2], P[BASE + 3]);   \
    unsigned b0 = cvtpk(P[BASE + 4], P[BASE + 5]), b1 = cvtpk(P[BASE + 6], P[BASE + 7]);                              \
    auto r0 = __builtin_amdgcn_permlane32_swap(a0, b0, false, false); auto r1 = __builtin_amdgcn_permlane32_swap(a1, b1, false, false); \
    u32x4 w = {r0[0], r1[0], r0[1], r1[1]}; OUT = *reinterpret_cast<bf16x8*>(&w); } while (0)
  PK4(p0, 0, pa0); PK4(p0, 8, pa1); PK4(p1, 0, pa2); PK4(p1, 8, pa3);
#undef PK4
}
__device__ __forceinline__ void qkt(f32x16& p0, f32x16& p1, const bf16_t* Ks, const bf16x8* qr, int r32, int hi) {
#pragma unroll
  for (int d0 = 0; d0 < 8; ++d0) { int cb = (d0 * 16 + hi * 8) * 2;
    bf16x8 b0 = *reinterpret_cast<const bf16x8*>((const char*)Ks + KSWZ(r32, cb));
    bf16x8 b1 = *reinterpret_cast<const bf16x8*>((const char*)Ks + KSWZ(32 + r32, cb));
    p0 = __builtin_amdgcn_mfma_f32_32x32x16_bf16(b0, qr[d0], p0, 0, 0, 0);
    p1 = __builtin_amdgcn_mfma_f32_32x32x16_bf16(b1, qr[d0], p1, 0, 0, 0); }
}
__device__ __forceinline__ int v_st(int k, int c) { const int kk = (k & ~0xC) | ((k & 4) << 1) | ((k & 8) >> 1); return ((kk >> 3) * 4 + (c >> 5)) * 512 + ((kk & 7) * 32 + (c & 31)) * 2; }
__device__ __forceinline__ int v_rd_base(int lane) { return ((lane & 3) << 3) | (((lane >> 2) & 3) << 6) | (((lane >> 4) & 1) << 5) | (((lane >> 5) & 1) << 8); }
constexpr int v_rd_off(int d0, int ks, int half) { return d0 * 512 + ks * 4096 + half * 2048; }
template <int OFF> __device__ __forceinline__ s16x4 tr_read(int vb) {
  s16x4 r; asm volatile("ds_read_b64_tr_b16 %0, %1 offset:%2" : "=&v"(r) : "v"(vb), "i"(OFF) : "memory"); return r;
}
template <int D0> __device__ __forceinline__ void pv_one(f32x16& od, int vb, bf16x8 pa0, bf16x8 pa1, bf16x8 pa2, bf16x8 pa3) {
  const s16x4 l0 = tr_read<v_rd_off(D0, 0, 0)>(vb), h0 = tr_read<v_rd_off(D0, 0, 1)>(vb), l1 = tr_read<v_rd_off(D0, 1, 0)>(vb), h1 = tr_read<v_rd_off(D0, 1, 1)>(vb);
  const s16x4 l2 = tr_read<v_rd_off(D0, 2, 0)>(vb), h2 = tr_read<v_rd_off(D0, 2, 1)>(vb), l3 = tr_read<v_rd_off(D0, 3, 0)>(vb), h3 = tr_read<v_rd_off(D0, 3, 1)>(vb);
  asm volatile("s_waitcnt lgkmcnt(0)" ::: "memory"); SBAR();
#define PK(L, H) (bf16x8){L[0], L[1], L[2], L[3], H[0], H[1], H[2], H[3]}
  od = __builtin_amdgcn_mfma_f32_32x32x16_bf16(pa0, PK(l0, h0), od, 0, 0, 0);
  od = __builtin_amdgcn_mfma_f32_32x32x16_bf16(pa1, PK(l1, h1), od, 0, 0, 0);
  od = __builtin_amdgcn_mfma_f32_32x32x16_bf16(pa2, PK(l2, h2), od, 0, 0, 0);
  od = __builtin_amdgcn_mfma_f32_32x32x16_bf16(pa3, PK(l3, h3), od, 0, 0, 0);
#undef PK
}
__device__ __forceinline__ void pv_d0(f32x16* o, int vb, bf16x8 pa0, bf16x8 pa1, bf16x8 pa2, bf16x8 pa3) {
  pv_one<0>(o[0], vb, pa0, pa1, pa2, pa3); pv_one<1>(o[1], vb, pa0, pa1, pa2, pa3); pv_one<2>(o[2], vb, pa0, pa1, pa2, pa3); pv_one<3>(o[3], vb, pa0, pa1, pa2, pa3);
}
__device__ __forceinline__ int kst(int t, int I, int pm) { return t < 4 ? 256 * I + 64 * t : 64 * (pm + t - 4); }
__device__ __forceinline__ void mkinit(f32x16& c0, f32x16& c1, int t, int I, int qrel, int hi, unsigned selmask, float sl, int pm) {
  float slv = sl; asm volatile("" : "+v"(slv));
  if (t < 4) {
    const int kb = 64 * t + 4 * hi, lim = qrel - kb; const float b0 = slv * (float)kb, b1 = slv * (float)(kb + 32);
#pragma unroll
    for (int r = 0; r < 16; ++r) { const int c = (r & 3) + 8 * (r >> 2);
      c0[r] = (c <= lim) ? fmaf(slv, (float)c, b0) : NEG; c1[r] = (c + 32 <= lim) ? fmaf(slv, (float)c, b1) : NEG; }
  } else {
    const int jt = pm + t - 4, pb = jt >> 2; const bool ok = (selmask >> pb) & 1u;
    const int kb = 64 * jt - 256 * I + 4 * hi;
    const float b0 = ok ? slv * (float)kb : NEG, b1 = ok ? slv * (float)(kb + 32) : NEG;
#pragma unroll
    for (int r = 0; r < 16; ++r) { const int c = (r & 3) + 8 * (r >> 2); c0[r] = fmaf(slv, (float)c, b0); c1[r] = fmaf(slv, (float)c, b1); }
  }
}
__device__ __forceinline__ void moba_unit(int b, int h, int I, const bf16_t* __restrict__ PROJ, const float* __restrict__ kmean, const float* __restrict__ kn2, bf16_t* __restrict__ ATT, char* lds) {
  int tid_ = threadIdx.x; asm volatile("" : "+v"(tid_));
  const int tid = tid_, wid = tid >> 6, lane = tid & 63, r32 = lane & 31, hi = lane >> 5;
  bf16_t* V_lds = (bf16_t*)lds; bf16_t* K_lds = (bf16_t*)(lds + 2 * SHM_V);
  float* wsf = (float*)(lds + OFF_WS) + wid * 64; float* li_l = wsf; float* al_l = wsf + 32;
  float* km = (float*)(lds + OFF_KM);
  const bf16_t* Qb = PROJ + (size_t)(b * SEQ + 256 * I) * INW + C_QA + h * D;
  const bf16_t* Kh = PROJ + (size_t)(b * SEQ) * INW + C_KA + h * D;
  const bf16_t* Vh = PROJ + (size_t)(b * SEQ) * INW + C_VA + h * D;
  float m_reg = -1e30f, l_reg = 0; f32x16 o[4] = {}; bf16x8 qr[8];
  const bf16_t* Qw = Qb + (size_t)(wid * QBLK + r32) * INW + hi * 8;
#pragma unroll
  for (int d0 = 0; d0 < 8; ++d0) qr[d0] = *reinterpret_cast<const bf16x8*>(Qw + d0 * 16);
  const int sr = tid >> 4, sc = (tid & 15) * 8, vst0 = v_st(sr, sc), vst1 = v_st(32 + sr, sc);
  constexpr int SDEPTH = MB_SDEPTH;
  struct { bf16x8 vs0, vs1, ks0, ks1; } sr_[SDEPTH];
#define SLOAD(i, k0) do { sr_[i].vs0 = *(const bf16x8*)(&Vh[(size_t)((k0) + sr) * INW + sc]); sr_[i].vs1 = *(const bf16x8*)(&Vh[(size_t)((k0) + 32 + sr) * INW + sc]); \
    sr_[i].ks0 = *(const bf16x8*)(&Kh[(size_t)((k0) + sr) * INW + sc]); sr_[i].ks1 = *(const bf16x8*)(&Kh[(size_t)((k0) + 32 + sr) * INW + sc]); } while (0)
  SLOAD(0, 256 * I);
  { const float* kg = kmean + (size_t)((b * AH + h) * 16) * D;
    for (int i = tid; i < 16 * D / 4; i += 512) ((f32x4*)km)[i] = ((const f32x4*)kg)[i]; }
  float* bnd = (float*)(lds + OFF_KM + 16 * D * 4);
  { float qs = 0.f;
#pragma unroll
    for (int d0 = 0; d0 < 8; ++d0)
#pragma unroll
      for (int j = 0; j < 8; ++j) { const float qv = __uint_as_float((unsigned)(unsigned short)qr[d0][j] << 16); qs = fmaf(qv, qv, qs); }
    { auto rr = __builtin_amdgcn_permlane32_swap(__float_as_uint(qs), __float_as_uint(qs), false, false); qs = __uint_as_float(rr[0]) + __uint_as_float(rr[1]); }
    qs = fmaxf(qs, __shfl_xor(qs, 1)); qs = fmaxf(qs, __shfl_xor(qs, 2)); qs = fmaxf(qs, __shfl_xor(qs, 4)); qs = fmaxf(qs, __shfl_xor(qs, 8)); qs = fmaxf(qs, __shfl_xor(qs, 16));
    if (lane == 0) bnd[16 + wid] = qs;
    if (tid < 16) { const float* kp = kn2 + ((b * AH + h) * 16 + tid) * 4; bnd[tid] = (kp[0] + kp[1]) + (kp[2] + kp[3]); } }
  __syncthreads();
  int p_min = 0;
  { float qm = 0.f, kmx = 0.f;
#pragma unroll
    for (int w = 0; w < 8; ++w) qm = fmaxf(qm, bnd[16 + w]);
    for (int n = 0; n <= I; ++n) kmx = fmaxf(kmx, bnd[n]);
    const float Bnd = SCALE * sqrtf(qm * kmx) * 1.03f, slope = exp2f(-(float)(h + 1));
    for (int jt = 0; jt < 4 * I; ++jt) if (slope * (float)(256 * I - 64 * jt - 63) > 2.f * Bnd + THR + 104.f) p_min = jt + 1;
    p_min = __builtin_amdgcn_readfirstlane(p_min) & ~1; }
  unsigned selmask = 0u;
  { float v1 = -INFINITY, v2 = -INFINITY, v3 = -INFINITY; int i1 = -1, i2 = -1, i3 = -1;
#pragma unroll 1
    for (int n = 0; n < I; ++n) {
      const float* kn = km + n * D + hi * 8; float g = 0.f;
#pragma unroll
      for (int d0 = 0; d0 < 8; ++d0) { const f32x4 k0 = *(const f32x4*)(kn + d0 * 16), k1 = *(const f32x4*)(kn + d0 * 16 + 4);
        float qf[8];
#pragma unroll
        for (int j = 0; j < 8; ++j) qf[j] = __uint_as_float((unsigned)(unsigned short)qr[d0][j] << 16);
        g += (qf[0] * k0.x + qf[1] * k0.y) + (qf[2] * k0.z + qf[3] * k0.w) + (qf[4] * k1.x + qf[5] * k1.y) + (qf[6] * k1.z + qf[7] * k1.w); }
      { auto rr = __builtin_amdgcn_permlane32_swap(__float_as_uint(g), __float_as_uint(g), false, false); g = __uint_as_float(rr[0]) + __uint_as_float(rr[1]); }
      if (g > v1) { v3 = v2; i3 = i2; v2 = v1; i2 = i1; v1 = g; i1 = n; }
      else if (g > v2) { v3 = v2; i3 = i2; v2 = g; i2 = n; }
      else if (g > v3) { v3 = g; i3 = n; }
    }
    if (i1 >= 0) selmask |= 1u << i1; if (i2 >= 0) selmask |= 1u << i2; if (i3 >= 0) selmask |= 1u << i3;
  }
  const float sl = exp2f(-(float)(h + 1)) / SCALE;
  const int qrel = wid * QBLK + r32;
  const int vb0 = (int)(uintptr_t)V_lds + v_rd_base(lane);
#define SWRITE(bb, i) do { *(bf16x8*)((char*)V_lds + (bb) * SHM_V + vst0) = sr_[i].vs0;          \
    *(bf16x8*)((char*)V_lds + (bb) * SHM_V + vst1) = sr_[i].vs1; int kc = sc * 2;               \
    *(bf16x8*)((char*)K_lds + (bb) * SHM_K + KSWZ(sr, kc)) = sr_[i].ks0;                       \
    *(bf16x8*)((char*)K_lds + (bb) * SHM_K + KSWZ(32 + sr, kc)) = sr_[i].ks1; } while (0)
#define SWAIT() do { if constexpr (SDEPTH == 2) asm volatile("s_waitcnt vmcnt(4)" ::: "memory"); else asm volatile("s_waitcnt vmcnt(0)" ::: "memory"); } while (0)
#define RESC(a) do { if (__any((a) < 1.f)) { if (hi == 0) al_l[r32] = (a); asm volatile("s_waitcnt lgkmcnt(0)" ::: "memory"); \
    _Pragma("unroll") for (int d = 0; d < 4; ++d) _Pragma("unroll") for (int r = 0; r < 16; ++r) o[d][r] *= al_l[crow(r, hi)]; } } while (0)
  f32x16 pA0, pA1, pB0, pB1; float mnA, mnB, alA, alB; bf16x8 pa0, pa1, pa2, pa3; const int NT = 4 * (I + 1) - p_min;
  constexpr int SE = 0, SO = SDEPTH - 1;
  static_assert(SE == 0, "the early tile load above uses slot SE");
  asm volatile("s_waitcnt vmcnt(0)" ::: "memory"); SWRITE(0, SE); __syncthreads();
  mkinit(pA0, pA1, 0, I, qrel, hi, selmask, sl, p_min); qkt(pA0, pA1, K_lds, qr, r32, hi); partialSM(pA0, pA1, m_reg, mnA, alA);
  SLOAD(SO, kst(1, I, p_min)); if constexpr (SDEPTH == 2) { if (2 < NT) SLOAD(SE, kst(2, I, p_min)); }
  SWAIT(); SWRITE(1, SO); __syncthreads();
  for (int j = 1; j + 1 < NT; j += 2) {
    SBAR(); mkinit(pB0, pB1, j, I, qrel, hi, selmask, sl, p_min); qkt(pB0, pB1, (bf16_t*)((char*)K_lds + SHM_K), qr, r32, hi);
    finishSM(pA0, pA1, alA, l_reg, pa0, pa1, pa2, pa3); SBAR();
    SLOAD(SO, kst(j + SDEPTH, I, p_min)); SBAR();
    pv_d0(o, vb0, pa0, pa1, pa2, pa3); partialSM(pB0, pB1, m_reg, mnB, alB);
    __syncthreads(); SWAIT(); SWRITE(0, SE);
    RESC(alB); __syncthreads();
    SBAR(); mkinit(pA0, pA1, j + 1, I, qrel, hi, selmask, sl, p_min); qkt(pA0, pA1, K_lds, qr, r32, hi);
    finishSM(pB0, pB1, alB, l_reg, pa0, pa1, pa2, pa3); SBAR();
    if (SDEPTH == 1 || j + 3 < NT) SLOAD(SE, kst(j + 1 + SDEPTH, I, p_min)); SBAR();
    pv_d0(o, vb0 + (int)SHM_V, pa0, pa1, pa2, pa3); partialSM(pA0, pA1, m_reg, mnA, alA);
    __syncthreads(); SWAIT(); SWRITE(1, SO);
    RESC(alA); __syncthreads();
  }
  SBAR(); mkinit(pB0, pB1, NT - 1, I, qrel, hi, selmask, sl, p_min); qkt(pB0, pB1, (bf16_t*)((char*)K_lds + SHM_K), qr, r32, hi);
  finishSM(pA0, pA1, alA, l_reg, pa0, pa1, pa2, pa3); SBAR();
  pv_d0(o, vb0, pa0, pa1, pa2, pa3); partialSM(pB0, pB1, m_reg, mnB, alB);
  __syncthreads(); RESC(alB);
  finishSM(pB0, pB1, alB, l_reg, pa0, pa1, pa2, pa3); SBAR();
  pv_d0(o, vb0 + (int)SHM_V, pa0, pa1, pa2, pa3);
  if (hi == 0) li_l[r32] = l_reg; asm volatile("s_waitcnt lgkmcnt(0)" ::: "memory");
  float rli[16];
#pragma unroll
  for (int r = 0; r < 16; ++r) rli[r] = __builtin_amdgcn_rcpf(li_l[crow(r, hi)]);
  __syncthreads();
  bf16_t* stg = (bf16_t*)(lds + wid * 8192);
#pragma unroll
  for (int r = 0; r < 16; ++r) { const int orow = crow(r, hi);
#pragma unroll
    for (int d0 = 0; d0 < 4; ++d0) stg[orow * 128 + d0 * 32 + r32] = (bf16_t)f2bf(o[d0][r] * rli[r]); }
  asm volatile("s_waitcnt lgkmcnt(0)" ::: "memory");
  bf16_t* Ow = ATT + (size_t)(b * SEQ + 256 * I + wid * QBLK) * DM + h * D;
#pragma unroll
  for (int i = 0; i < 8; ++i) { const int row = i * 4 + (lane >> 4), ch = lane & 15; const u32x4 v = *(const u32x4*)(stg + row * 128 + ch * 8); *(u32x4*)(Ow + (size_t)row * DM + ch * 8) = v; }
  __syncthreads();
#undef SLOAD
#undef SWRITE
#undef SWAIT
#undef RESC
}
#undef KSWZ
#undef SBAR
}


namespace rt {
using mb::f32x16; using mb::s16x4; using mb::crow; using mb::cvtpk;
#define SBAR() __builtin_amdgcn_sched_barrier(0)
__device__ __forceinline__ unsigned off_a(unsigned row, unsigned ch) { return 2048u * (row >> 3) + 512u * (ch >> 2) + 64u * (row & 7) + 16u * ((ch & 3) ^ ((row >> 2) & 3)); }
template <int OFF> __device__ __forceinline__ s16x4 trr(unsigned addr) { s16x4 r; asm volatile("ds_read_b64_tr_b16 %0, %1 offset:%2" : "=&v"(r) : "v"(addr), "i"(OFF) : "memory"); return r; }
__device__ __forceinline__ u32x4 scale8(u32x4 v, float f) {
  u32x4 o;
  o.x = cvtpk(__uint_as_float(v.x << 16) * f, __uint_as_float(v.x & 0xffff0000u) * f); o.y = cvtpk(__uint_as_float(v.y << 16) * f, __uint_as_float(v.y & 0xffff0000u) * f);
  o.z = cvtpk(__uint_as_float(v.z << 16) * f, __uint_as_float(v.z & 0xffff0000u) * f); o.w = cvtpk(__uint_as_float(v.w << 16) * f, __uint_as_float(v.w & 0xffff0000u) * f);
  return o;
}
__device__ __forceinline__ float lg2gamma(int hr) { return log2f(1.f - exp2f(-5.f - (float)hr)); }
#define PKF(L, H) (bf16x8){L[0], L[1], L[2], L[3], H[0], H[1], H[2], H[3]}

template <int KS> __device__ __forceinline__ void kv_step(f32x16 (&acc)[8], unsigned bv0, unsigned bv1, unsigned bk0, unsigned bk1) {
  const s16x4 al = trr<4096 * KS>(bv0), ah = trr<4096 * KS>(bv1);
  s16x4 bl[8], bh[8];
#define RD(cb) bl[cb] = trr<4096 * KS + 512 * (cb & 3) + 32768 * (cb >> 2)>(bk0); bh[cb] = trr<4096 * KS + 512 * (cb & 3) + 32768 * (cb >> 2)>(bk1);
  RD(0) RD(1) RD(2) RD(3) RD(4) RD(5) RD(6) RD(7)
#undef RD
  asm volatile("s_waitcnt lgkmcnt(0)" ::: "memory"); SBAR();
  const bf16x8 a = PKF(al, ah);
#pragma unroll
  for (int cb = 0; cb < 8; ++cb) acc[cb] = __builtin_amdgcn_mfma_f32_32x32x16_bf16(a, PKF(bl[cb], bh[cb]), acc[cb], 0, 0, 0);
}
__device__ __forceinline__ void kv_unit(int b, int hr, int n, const bf16_t* __restrict__ PROJ, bf16_t* __restrict__ ST, char* lds) {
  int tid_ = threadIdx.x; asm volatile("" : "+v"(tid_));
  const int tid = tid_, wid = __builtin_amdgcn_readfirstlane(tid >> 6), lane = tid & 63, r32 = lane & 31, hi = lane >> 5;
  const float L2G = lg2gamma(hr);
  const bf16_t* Kg = PROJ + (size_t)(b * SEQ + n * 128) * INW + C_KR + hr * RD;
  const bf16_t* Vg = PROJ + (size_t)(b * SEQ + n * 128) * INW + C_VR + hr * RD;
#pragma unroll
  for (int i = 0; i < 8; ++i) { const int idx = tid + 512 * i, row = idx >> 5, c32 = idx & 31, img = c32 >> 4, ch = c32 & 15;
    const u32x4 kv = *(const u32x4*)(Kg + (size_t)row * INW + c32 * 8); u32x4 vv = *(const u32x4*)(Vg + (size_t)row * INW + c32 * 8);
    vv = scale8(vv, exp2f(L2G * (float)(127 - row)) * 0.0625f);
    *(u32x4*)(lds + img * 32768 + off_a(row, ch)) = vv; *(u32x4*)(lds + 65536 + img * 32768 + off_a(row, ch)) = kv; }
  __syncthreads();
  f32x16 acc[8];
#pragma unroll
  for (int cb = 0; cb < 8; ++cb) acc[cb] = f32x16{};
  const unsigned q = (lane & 15) >> 2, p = lane & 3, blk = (lane >> 4) & 1;
  const unsigned lp = 2048u * hi + 64u * q + 8u * (p & 1), x2 = 2u * blk + (p >> 1);
  const unsigned o0 = lp + 16u * (x2 ^ ((2u * hi) & 3u)), o1 = lp + 256u + 16u * (x2 ^ ((2u * hi + 1u) & 3u));
  const unsigned l0 = (unsigned)(uintptr_t)lds;
  const unsigned bv0 = l0 + o0 + 512u * (wid & 3) + 32768u * (wid >> 2), bv1 = l0 + o1 + 512u * (wid & 3) + 32768u * (wid >> 2);
  const unsigned bk0 = l0 + 65536u + o0, bk1 = l0 + 65536u + o1;
  kv_step<0>(acc, bv0, bv1, bk0, bk1); kv_step<1>(acc, bv0, bv1, bk0, bk1); kv_step<2>(acc, bv0, bv1, bk0, bk1); kv_step<3>(acc, bv0, bv1, bk0, bk1);
  kv_step<4>(acc, bv0, bv1, bk0, bk1); kv_step<5>(acc, bv0, bv1, bk0, bk1); kv_step<6>(acc, bv0, bv1, bk0, bk1); kv_step<7>(acc, bv0, bv1, bk0, bk1);
  __syncthreads();
  char* stg = lds + wid * 16384;
#pragma unroll
  for (int cb = 0; cb < 8; ++cb)
#pragma unroll
    for (int r = 0; r < 16; ++r) { const int row = crow(r, hi), chunk = cb * 4 + (r32 >> 3);
      *(bf16_t*)(stg + row * 512 + ((chunk ^ row) << 4) + (r32 & 7) * 2) = (bf16_t)f2bf(acc[cb][r]); }
  asm volatile("s_waitcnt lgkmcnt(0)" ::: "memory");
  bf16_t* dst = ST + ((size_t)((b * RH + hr) * 31 + n)) * 65536 + (size_t)(((wid >> 2) * 4 + (wid & 3)) * 16) * 512;
#pragma unroll
  for (int d0 = 0; d0 < 16; ++d0) { const u32x4 v = *(const u32x4*)(stg + r32 * 512 + (((2 * d0 + hi) ^ r32) << 4)); *(u32x4*)(dst + (size_t)d0 * 512 + lane * 8) = v; }
  __syncthreads();
}

constexpr int CH_NDV = 4;
template <int KS> __device__ __forceinline__ void ch_kstep(s16x4& kl, s16x4& kh, s16x4 (&vl)[CH_NDV], s16x4 (&vh)[CH_NDV], unsigned bk0, unsigned bk1, unsigned bv0, unsigned bv1) {
  kl = trr<4096 * KS>(bk0); kh = trr<4096 * KS>(bk1);
  vl[0] = trr<4096 * KS>(bv0); vh[0] = trr<4096 * KS>(bv1);
  if constexpr (CH_NDV > 1) { vl[1] = trr<4096 * KS + 512>(bv0); vh[1] = trr<4096 * KS + 512>(bv1); }
  if constexpr (CH_NDV > 2) { vl[2] = trr<4096 * KS + 1024>(bv0); vh[2] = trr<4096 * KS + 1024>(bv1); vl[3] = trr<4096 * KS + 1536>(bv0); vh[3] = trr<4096 * KS + 1536>(bv1); }
}
__device__ __forceinline__ void kvchain_unit(int b, int hr, int sl, const bf16_t* __restrict__ PROJ, bf16_t* __restrict__ ST, char* lds) {
  int tid_ = threadIdx.x; asm volatile("" : "+v"(tid_));
  const int tid = tid_, wid = __builtin_amdgcn_readfirstlane(tid >> 6), lane = tid & 63, hi = lane >> 5;
  const float L2G = lg2gamma(hr), cd = exp2f(128.f * L2G);
  const bf16_t* Kg = PROJ + (size_t)(b * SEQ) * INW + C_KR + hr * RD;
  const bf16_t* Vg = PROJ + (size_t)(b * SEQ) * INW + C_VR + hr * RD + sl * (32 * CH_NDV);
  const int vrow = tid >> 2, vc4 = tid & 3;
  const float vscale = exp2f(L2G * (float)(127 - vrow)) * 0.0625f;
  struct ChBuf { u32x4 k[8]; u32x4 v[CH_NDV]; } bufA;
#define CH_LOAD(buf, n_) do { const bf16_t* kp_ = Kg + (size_t)((n_) * 128) * INW; const bf16_t* vp_ = Vg + (size_t)((n_) * 128) * INW; \
    _Pragma("unroll") for (int i = 0; i < 8; ++i) { const int idx = tid + 512 * i, row = idx >> 5, c32 = idx & 31; buf.k[i] = *(const u32x4*)(kp_ + (size_t)row * INW + c32 * 8); } \
    _Pragma("unroll") for (int j = 0; j < CH_NDV; ++j) buf.v[j] = *(const u32x4*)(vp_ + (size_t)vrow * INW + (vc4 + 4 * j) * 8); } while (0)
#define CH_WRITE(buf) do { _Pragma("unroll") for (int i = 0; i < 8; ++i) { const int idx = tid + 512 * i, row = idx >> 5, c32 = idx & 31, img = c32 >> 4, ch = c32 & 15; \
      *(u32x4*)(lds + 65536 + img * 32768 + off_a(row, ch)) = buf.k[i]; } \
    _Pragma("unroll") for (int j = 0; j < CH_NDV; ++j) { const int c32 = sl * (4 * CH_NDV) + vc4 + 4 * j; \
      *(u32x4*)(lds + (c32 >> 4) * 32768 + off_a(vrow, c32 & 15)) = scale8(buf.v[j], vscale); } } while (0)
  const unsigned q = (lane & 15) >> 2, p = lane & 3, blk = (lane >> 4) & 1;
  const unsigned lp = 2048u * hi + 64u * q + 8u * (p & 1), x2 = 2u * blk + (p >> 1);
  const unsigned o0 = lp + 16u * (x2 ^ ((2u * hi) & 3u)), o1 = lp + 256u + 16u * (x2 ^ ((2u * hi + 1u) & 3u));
  const unsigned l0 = (unsigned)(uintptr_t)lds;
  const unsigned vb_ = (unsigned)(sl * CH_NDV);
  const unsigned bv0 = l0 + o0 + 512u * (vb_ & 3u) + 32768u * (vb_ >> 2), bv1 = l0 + o1 + 512u * (vb_ & 3u) + 32768u * (vb_ >> 2);
  const unsigned bk0 = l0 + 65536u + o0 + 512u * (wid & 3) + 32768u * (wid >> 2), bk1 = l0 + 65536u + o1 + 512u * (wid & 3) + 32768u * (wid >> 2);
  f32x16 acc[CH_NDV];
#pragma unroll
  for (int m = 0; m < CH_NDV; ++m) acc[m] = f32x16{};
  bf16_t* dst0 = ST + ((size_t)((b * RH + hr) * 31)) * 65536 + (size_t)(sl * CH_NDV * 16 + 2 * wid) * 512 + lane * 8;
#define CH_PK4(P, BASE, OUT) do { unsigned a0 = cvtpk(P[BASE + 0], P[BASE + 1]), a1 = cvtpk(P[BASE + 2], P[BASE + 3]);   \
    unsigned b0 = cvtpk(P[BASE + 4], P[BASE + 5]), b1 = cvtpk(P[BASE + 6], P[BASE + 7]);                              \
    auto r0 = __builtin_amdgcn_permlane32_swap(a0, b0, false, false); auto r1 = __builtin_amdgcn_permlane32_swap(a1, b1, false, false); \
    OUT = (u32x4){r0[0], r1[0], r0[1], r1[1]}; } while (0)
#define CH_PART(KS0) do { s16x4 kl[2], kh_[2], vl[2][CH_NDV], vh[2][CH_NDV]; \
    ch_kstep<(KS0)>(kl[0], kh_[0], vl[0], vh[0], bk0, bk1, bv0, bv1); ch_kstep<(KS0) + 1>(kl[1], kh_[1], vl[1], vh[1], bk0, bk1, bv0, bv1); \
    asm volatile("s_waitcnt lgkmcnt(0)" ::: "memory"); SBAR(); \
    _Pragma("unroll") for (int ks = 0; ks < 2; ++ks) _Pragma("unroll") for (int m = 0; m < CH_NDV; ++m) \
      acc[m] = __builtin_amdgcn_mfma_f32_32x32x16_bf16(PKF(kl[ks], kh_[ks]), PKF(vl[ks][m], vh[ks][m]), acc[m], 0, 0, 0); } while (0)
#define CH_STEP(buf, n_) do { \
    __syncthreads(); \
    CH_WRITE(buf); \
    if ((n_) + 1 < 31) CH_LOAD(buf, (n_) + 1); \
    _Pragma("unroll") for (int m = 0; m < CH_NDV; ++m) _Pragma("unroll") for (int r = 0; r < 16; ++r) acc[m][r] *= cd; \
    __syncthreads(); \
    CH_PART(0); CH_PART(2); CH_PART(4); CH_PART(6); \
    { bf16_t* dst = dst0 + (size_t)(n_) * 65536; \
      _Pragma("unroll") for (int m = 0; m < CH_NDV; ++m) { u32x4 f0, f1; CH_PK4(acc[m], 0, f0); CH_PK4(acc[m], 8, f1); \
        *(u32x4*)(dst + (size_t)(m * 16) * 512) = f0; *(u32x4*)(dst + (size_t)(m * 16 + 1) * 512) = f1; } } \
  } while (0)
  static_assert(CH_NDV == 1 || CH_NDV == 2 || CH_NDV == 4, "a slice must not straddle an LDS image");
  CH_LOAD(bufA, 0);
#pragma unroll 1
  for (int n = 0; n < 31; ++n) CH_STEP(bufA, n);
  __syncthreads();
#undef CH_STEP
#undef CH_PART
#undef CH_PK4
#undef CH_LOAD
#undef CH_WRITE
}

#define KSWZ16(row, colB) ((row) * 512 + ((colB) ^ (((row) & 15) << 4)))
template <int KT> __device__ __forceinline__ void ret_intra(f32x16* o, const bf16x8* qr, const char* Kl, int vb, int irow, int hi, int r32, float L2G) {
  f32x16 p0 = f32x16{}, p1 = f32x16{};
#pragma unroll
  for (int d0 = 0; d0 < 16; ++d0) { const int cb = (d0 * 16 + hi * 8) * 2;
    const bf16x8 b0 = *reinterpret_cast<const bf16x8*>(Kl + KSWZ16(64 * KT + r32, cb));
    const bf16x8 b1 = *reinterpret_cast<const bf16x8*>(Kl + KSWZ16(64 * KT + 32 + r32, cb));
    p0 = __builtin_amdgcn_mfma_f32_32x32x16_bf16(b0, qr[d0], p0, 0, 0, 0);
    p1 = __builtin_amdgcn_mfma_f32_32x32x16_bf16(b1, qr[d0], p1, 0, 0, 0);
    if ((d0 & 3) == 3) { asm volatile("" ::: "memory"); SBAR(); } }
  const int dbase = irow - 64 * KT - 4 * hi; float lg = L2G; asm volatile("" : "+v"(lg));
#pragma unroll
  for (int r = 0; r < 16; ++r) { const int c = (r & 3) + 8 * (r >> 2); const int d0_ = dbase - c, d1_ = dbase - c - 32;
    p0[r] = (d0_ >= 0) ? p0[r] * (__builtin_amdgcn_exp2f(lg * (float)d0_) * 0.0625f) : 0.f;
    p1[r] = (d1_ >= 0) ? p1[r] * (__builtin_amdgcn_exp2f(lg * (float)d1_) * 0.0625f) : 0.f; }
  bf16x8 pa0, pa1, pa2, pa3;
#define PK4(P, BASE, OUT) do { unsigned a0 = cvtpk(P[BASE + 0], P[BASE + 1]), a1 = cvtpk(P[BASE + 2], P[BASE + 3]);   \
    unsigned b0 = cvtpk(P[BASE + 4], P[BASE + 5]), b1 = cvtpk(P[BASE + 6], P[BASE + 7]);                              \
    auto r0 = __builtin_amdgcn_permlane32_swap(a0, b0, false, false); auto r1 = __builtin_amdgcn_permlane32_swap(a1, b1, false, false); \
    u32x4 w = {r0[0], r1[0], r0[1], r1[1]}; OUT = *reinterpret_cast<bf16x8*>(&w); } while (0)
  PK4(p0, 0, pa0); PK4(p0, 8, pa1); PK4(p1, 0, pa2); PK4(p1, 8, pa3);
#undef PK4
  mb::pv_d0(o, vb, pa0, pa1, pa2, pa3);
}
template <int STOP> __device__ __forceinline__ void ret_unit(int b, int hr, int n, const bf16_t* __restrict__ PROJ, const bf16_t* __restrict__ ST, const float* __restrict__ ret_norm_w,
                                         bf16_t* __restrict__ ATT, char* lds, float* ssx) {
  int tid_ = threadIdx.x; asm volatile("" : "+v"(tid_));
  const int tid = tid_, wid = __builtin_amdgcn_readfirstlane(tid >> 6), lane = tid & 63, r32 = lane & 31, hi = lane >> 5, rg = wid >> 1, dh = wid & 1;
  const float L2G = lg2gamma(hr);
  const size_t row0 = (size_t)(b * SEQ + n * 128);
  const bf16_t* Qg = PROJ + row0 * INW + C_QR + hr * RD;
  const bf16_t* Kg = PROJ + row0 * INW + C_KR + hr * RD;
  const bf16_t* Vg = PROJ + row0 * INW + C_VR + hr * RD;
  u32x4 kvr[8], vvr[8];
#pragma unroll
  for (int i = 0; i < 8; ++i) { const int idx = tid + 512 * i, row = idx >> 5, c = (idx & 31) * 8;
    kvr[i] = *(const u32x4*)(Kg + (size_t)row * INW + c); vvr[i] = *(const u32x4*)(Vg + (size_t)row * INW + c); }
  bf16x8 qr[16];
  { const bf16_t* Qw = Qg + (size_t)(rg * 32 + r32) * INW + hi * 8;
#pragma unroll
    for (int d0 = 0; d0 < 16; ++d0) qr[d0] = *reinterpret_cast<const bf16x8*>(Qw + d0 * 16); }
  const bf16_t* Sg = ST + ((size_t)((b * RH + hr) * 31 + (n > 0 ? n - 1 : 0))) * 65536 + (size_t)(dh * 4 * 16) * 512 + lane * 8;
#define LDF(dst, d0_) do { _Pragma("unroll") for (int c = 0; c < 4; ++c) dst[c] = *reinterpret_cast<const bf16x8*>(Sg + (size_t)(c * 16 + (d0_)) * 512); } while (0)
#define MMF(src, d0_) do { _Pragma("unroll") for (int c = 0; c < 4; ++c) o[c] = __builtin_amdgcn_mfma_f32_32x32x16_bf16(qr[d0_], src[c], o[c], 0, 0, 0); } while (0)
  bf16x8 fA[4], fB[4], fC[4], fD[4];
  if (n > 0) { LDF(fA, 0); LDF(fB, 1); LDF(fC, 2); }
  asm volatile("" ::: "memory");
#pragma unroll
  for (int i = 0; i < 8; ++i) { const int idx = tid + 512 * i, row = idx >> 5, c = (idx & 31) * 8;
    *(u32x4*)(lds + 65536 + KSWZ16(row, c * 2)) = kvr[i];
    *(u32x4*)(lds + ((row >> 6) * 2 + (c >> 7)) * 16384 + mb::v_st(row & 63, c & 127)) = vvr[i]; }
  f32x16 o[4];
#pragma unroll
  for (int c = 0; c < 4; ++c) o[c] = f32x16{};
  if constexpr (STOP == 1) { _Pragma("unroll") for (int d0 = 0; d0 < 16; ++d0) asm volatile("" :: "v"(qr[d0])); __syncthreads(); return; }
  if (n > 0) {
    LDF(fD, 3); asm volatile("" ::: "memory"); MMF(fA, 0);
    LDF(fA, 4); asm volatile("" ::: "memory"); MMF(fB, 1);
    LDF(fB, 5); asm volatile("" ::: "memory"); MMF(fC, 2);
    LDF(fC, 6); asm volatile("" ::: "memory"); MMF(fD, 3);
    LDF(fD, 7); asm volatile("" ::: "memory"); MMF(fA, 4);
    LDF(fA, 8); asm volatile("" ::: "memory"); MMF(fB, 5);
    LDF(fB, 9); asm volatile("" ::: "memory"); MMF(fC, 6);
    LDF(fC, 10); asm volatile("" ::: "memory"); MMF(fD, 7);
    LDF(fD, 11); asm volatile("" ::: "memory"); MMF(fA, 8);
    LDF(fA, 12); asm volatile("" ::: "memory"); MMF(fB, 9);
    LDF(fB, 13); asm volatile("" ::: "memory"); MMF(fC, 10);
    LDF(fC, 14); asm volatile("" ::: "memory"); MMF(fD, 11);
    LDF(fD, 15); asm volatile("" ::: "memory"); MMF(fA, 12);
    MMF(fB, 13); MMF(fC, 14); MMF(fD, 15);
#undef LDF
#undef MMF
#pragma unroll
    for (int r = 0; r < 16; ++r) { const float f = __builtin_amdgcn_exp2f(L2G * (float)(rg * 32 + crow(r, hi) + 1));
#pragma unroll
      for (int c = 0; c < 4; ++c) o[c][r] *= f; }
  }
  __syncthreads();
  if constexpr (STOP == 2) { _Pragma("unroll") for (int c = 0; c < 4; ++c) asm volatile("" :: "v"(o[c])); return; }
  const int vb0 = (int)(uintptr_t)lds + mb::v_rd_base(lane);
  const char* Kl = lds + 65536;
  const int irow = rg * 32 + r32;
  ret_intra<0>(o, qr, Kl, vb0 + dh * 16384, irow, hi, r32, L2G);
  if (rg >= 2) ret_intra<1>(o, qr, Kl, vb0 + (2 + dh) * 16384, irow, hi, r32, L2G);
  if constexpr (STOP == 3) { _Pragma("unroll") for (int c = 0; c < 4; ++c) asm volatile("" :: "v"(o[c])); __syncthreads(); return; }
  const int ccol = hr * RD + dh * 128;
  u32x4 gv[8];
#pragma unroll
  for (int i = 0; i < 8; ++i) gv[i] = *(const u32x4*)(PROJ + (row0 + rg * 32 + i * 4 + (lane >> 4)) * INW + C_GR + ccol + (lane & 15) * 8);
#pragma unroll
  for (int r = 0; r < 16; ++r) { float s = 0.f;
#pragma unroll
    for (int c = 0; c < 4; ++c) s += o[c][r] * o[c][r];
    s += __shfl_xor(s, 1); s += __shfl_xor(s, 2); s += __shfl_xor(s, 4); s += __shfl_xor(s, 8); s += __shfl_xor(s, 16);
    if (r32 == 0) ssx[(rg * 2 + dh) * 32 + crow(r, hi)] = s; }
  __syncthreads();
  bf16_t* stg = (bf16_t*)(lds + wid * 8192);
#pragma unroll
  for (int r = 0; r < 16; ++r) { const int rr = crow(r, hi); const float rs = rsqrtf((ssx[(rg * 2) * 32 + rr] + ssx[(rg * 2 + 1) * 32 + rr]) * (1.f / RD) + EPS);
#pragma unroll
    for (int c = 0; c < 4; ++c) stg[rr * 128 + c * 32 + r32] = (bf16_t)f2bf(o[c][r] * rs); }
  asm volatile("s_waitcnt lgkmcnt(0)" ::: "memory");
#pragma unroll
  for (int i = 0; i < 8; ++i) { const int row = i * 4 + (lane >> 4), ch = lane & 15;
    const u32x4 v = *(const u32x4*)(stg + row * 128 + ch * 8);
    const u32x4 g = gv[i];
    const f32x4 w0 = *(const f32x4*)(ret_norm_w + ccol + ch * 8), w1 = *(const f32x4*)(ret_norm_w + ccol + ch * 8 + 4);
#define E2(vw, gw, wa, wb) cvtpk(__uint_as_float((vw) << 16) * (wa) * pg8::silu_fast(__uint_as_float((gw) << 16)), __uint_as_float((vw) & 0xffff0000u) * (wb) * pg8::silu_fast(__uint_as_float((gw) & 0xffff0000u)))
    u32x4 ov; ov.x = E2(v.x, g.x, w0.x, w0.y); ov.y = E2(v.y, g.y, w0.z, w0.w); ov.z = E2(v.z, g.z, w1.x, w1.y); ov.w = E2(v.w, g.w, w1.z, w1.w);
#undef E2
    *(u32x4*)(ATT + (row0 + rg * 32 + row) * DM + AW + ccol + ch * 8) = ov; }
  __syncthreads();
}
#undef KSWZ16
#undef PKF
#undef SBAR
}

struct Args { const float* in[17]; float* out; unsigned char* ws; int ph_lo, ph_hi, li, pad; };
constexpr int CH_PER = 8 / rt::CH_NDV, NQ_ATT = NB * AH * 16, NQ_CH = NB * RH * CH_PER, CH_COST = 14;
struct AttTab { unsigned short v[NQ_ATT + NQ_CH]; };
constexpr AttTab make_att_tab() {
    AttTab t{}; const int keep[AH] = {2, 3, 5, 10, 16, 16, 16, 16}; int n = 0;
    for (int c = 17; c >= 1; --c) {
        if (c == CH_COST) for (int k = 0; k < NQ_CH; ++k) t.v[n++] = (unsigned short)(NQ_ATT + k);
        for (int u = 0; u < NQ_ATT; ++u) { const int I = u & 15, h = (u >> 4) & 7; const int cu = (I < keep[h] ? I : keep[h]) + 1; if (cu == c) t.v[n++] = (unsigned short)u; } }
    return t;
}
__device__ const AttTab ATT_TAB = make_att_tab();

struct Frame {
    LAS unsigned char* lds; volatile LAS unsigned* MISC; unsigned* ctl;
    int tid, lane, wave, G, vcu;
};
__device__ __forceinline__ float wave_sum(float v) {
#pragma unroll
    for (int o = 1; o < 64; o <<= 1) v += __shfl_xor(v, o);
    return v;
}
struct TrItem { const float* W; void* WT; int N, k0, n0, ldk; long drow; float scale; };
__device__ __forceinline__ void tr_load(const TrItem& d, float (&tv)[32], int lane) {
#pragma unroll
    for (int i = 0; i < 32; ++i) tv[i] = d.W[(size_t)(d.k0 + 2 * i + (lane >> 5)) * d.N + d.n0 + (lane & 31)];
}
__device__ __forceinline__ void tr_finish(const TrItem& d, const float (&tv)[32], LAS float* scr, int lane) {
#pragma unroll
    for (int i = 0; i < 32; ++i) scr[(2 * i + (lane >> 5)) * 33 + (lane & 31)] = tv[i];
    LDS_WAIT(); asm volatile("" ::: "memory");
    if (d.scale == 0.f) {
        const int c = lane & 7;
#pragma unroll
        for (int j = 0; j < 4; ++j) { const int n = (lane >> 3) + 8 * j; const LAS float* s = scr + (8 * c) * 33 + n;
            u32x4 o; o.x = pg8::cvt_pk_bf16(s[0 * 33], s[1 * 33]); o.y = pg8::cvt_pk_bf16(s[2 * 33], s[3 * 33]); o.z = pg8::cvt_pk_bf16(s[4 * 33], s[5 * 33]); o.w = pg8::cvt_pk_bf16(s[6 * 33], s[7 * 33]);
            *(u32x4*)((bf16_t*)d.WT + (size_t)(d.drow + n) * d.ldk + d.k0 + 8 * c) = o; }
    } else {
        const int c = lane & 3; const float sc = d.scale;
#pragma unroll
        for (int j = 0; j < 2; ++j) { const int n = (lane >> 2) + 16 * j; const LAS float* s = scr + (16 * c) * 33 + n;
            u32x4 o; o.x = cvt4_fp8(s[0 * 33] * sc, s[1 * 33] * sc, s[2 * 33] * sc, s[3 * 33] * sc); o.y = cvt4_fp8(s[4 * 33] * sc, s[5 * 33] * sc, s[6 * 33] * sc, s[7 * 33] * sc);
            o.z = cvt4_fp8(s[8 * 33] * sc, s[9 * 33] * sc, s[10 * 33] * sc, s[11 * 33] * sc); o.w = cvt4_fp8(s[12 * 33] * sc, s[13 * 33] * sc, s[14 * 33] * sc, s[15 * 33] * sc);
            *(u32x4*)((unsigned char*)d.WT + (size_t)(d.drow + n) * d.ldk + d.k0 + 16 * c) = o; }
    }
    LDS_WAIT(); asm volatile("" ::: "memory");
}
#define TR_STREAM(DECODE, it0, step, itend) do { int it_ = (it0); float tvA[32], tvB[32]; TrItem dA, dB; \
    if (it_ < (itend)) { DECODE(dA, it_); tr_load(dA, tvA, F.lane); } \
    while (it_ < (itend)) { int nx_ = it_ + (step); if (nx_ < (itend)) { DECODE(dB, nx_); tr_load(dB, tvB, F.lane); } tr_finish(dA, tvA, scr, F.lane); it_ = nx_; if (it_ >= (itend)) break; \
        nx_ = it_ + (step); if (nx_ < (itend)) { DECODE(dA, nx_); tr_load(dA, tvA, F.lane); } tr_finish(dB, tvB, scr, F.lane); it_ = nx_; } } while (0)

__global__ void __launch_bounds__(NTHR, 2) mk_fwd(Args args) {
    extern __shared__ __attribute__((aligned(16))) unsigned char lds_raw[];
    Frame F;
    F.lds = (LAS unsigned char*)lds_raw;
    F.MISC = (volatile LAS unsigned*)(F.lds + MISC_OFF);
    F.tid = threadIdx.x; F.lane = F.tid & 63; F.wave = __builtin_amdgcn_readfirstlane(F.tid >> 6);
    F.G = gridDim.x; { const int bx = blockIdx.x; F.vcu = (F.G % 8 == 0) ? (bx % 8) * (F.G / 8) + bx / 8 : bx; }
    unsigned char* ws = args.ws;
    F.ctl = (unsigned*)(ws + WS_CTL);
    for (int u = F.tid; u < (LDS_BYTES - LDSCTL_OFF) / 4; u += NTHR) ((LAS unsigned*)(F.lds + LDSCTL_OFF))[u] = 0u;
    __syncthreads();
    XcdBarrier bar = xcd_barrier_post((unsigned*)(ws + WS_CTL + CTL_BAR) + args.li * 4096, F.MISC + 8);
    const int lo = args.ph_lo, hi = args.ph_hi;
#define IN(k) (lo <= (k) && (k) < hi)
#define REPS(k) ((k) == PROBE_PHASE ? 1 + PROBE_REPS : 1)
#define BOTH(k) (IN(k) && IN((k) + 1))
#define GRID_BAR() xcd_barrier(bar)
#define REFRESH() do { int t_ = threadIdx.x; asm volatile("" : "+v"(t_)); F.tid = t_; F.lane = t_ & 63; } while (0)
    const float* x = args.in[0]; const float* cvec = args.in[1]; const float* w_ada = args.in[2]; const float* b_ada = args.in[3];
    const float* norm_mix_w = args.in[4]; const float* w_in = args.in[5]; const float* w_out = args.in[7];
    const float* w_group = args.in[9]; const float* w_router = args.in[11];
    const float* w1 = args.in[13]; const float* w3 = args.in[14]; const float* w2 = args.in[15];
    float* modp = (float*)(ws + WS_MODP); float* mod = (float*)(ws + WS_MOD);
    bf16_t* Wt_in = (bf16_t*)(ws + WS_WIN); bf16_t* Wt_out = (bf16_t*)(ws + WS_WOUT); bf16_t* W13t = (bf16_t*)(ws + WS_W13); bf16_t* W2t = (bf16_t*)(ws + WS_W2);
    bf16_t* Hb = (bf16_t*)(ws + WS_H); bf16_t* PROJ = (bf16_t*)(ws + WS_PROJ); bf16_t* ATT = (bf16_t*)(ws + WS_ATT);
    float* kmean = (float*)(ws + WS_CTL + CTL_KMEAN);

    if (IN(0)) {
        REFRESH();
        _Pragma("unroll 1") for (int rep_ = 0; rep_ < REPS(0); ++rep_) {
        for (int it = blockIdx.x; it < 256; it += F.G) {
            const int kc = it & 3, cg = it >> 2;
            LAS float* sc = (LAS float*)(F.lds + RING_OFF);
            LAS float* red = sc + 4 * 512;
#pragma unroll
            for (int b = 0; b < 4; ++b) sc[b * 512 + F.tid] = silu_f(cvec[b * DM + kc * 512 + F.tid]);
            __syncthreads();
            const int rg = F.tid / 48, c4 = F.tid - rg * 48;
            if (rg < 8) {
                f32x4 acc[4];
#pragma unroll
                for (int b = 0; b < 4; ++b) acc[b] = (f32x4){0.f, 0.f, 0.f, 0.f};
                const float* wp = w_ada + (size_t)(kc * 512 + rg * 64) * NMOD + cg * 192 + c4 * 4;
#pragma unroll 1
                for (int r0 = 0; r0 < 64; r0 += 16) {
                    f32x4 wv[16];
#pragma unroll
                    for (int r = 0; r < 16; ++r) wv[r] = *(const f32x4*)(wp + (size_t)(r0 + r) * NMOD);
#pragma unroll
                    for (int r = 0; r < 16; ++r)
#pragma unroll
                        for (int b = 0; b < 4; ++b) acc[b] += wv[r] * sc[b * 512 + rg * 64 + r0 + r];
                }
#pragma unroll
                for (int b = 0; b < 4; ++b) *(LAS f32x4*)(red + (rg * 4 + b) * 192 + c4 * 4) = acc[b];
            }
            __syncthreads();
            for (int o = F.tid; o < 4 * 192; o += NTHR) { const int b = o / 192, c = o - b * 192; float v = 0.f;
#pragma unroll
                for (int g = 0; g < 8; ++g) v += red[(g * 4 + b) * 192 + c];
                modp[(size_t)(kc * 4 + b) * NMOD + cg * 192 + c] = v; }
            __syncthreads();
        }
        }
        if (BOTH(0)) xcd_arrive(bar, (unsigned*)(ws + WS_CTL + CTL_BAR) + 15 * 4096);
    }

    if (IN(1)) {
        REFRESH();
        _Pragma("unroll 1") for (int rep_ = 0; rep_ < REPS(1); ++rep_) {
        auto do_rows = [&]() {
        if (BOTH(0)) xcd_wait(bar, (unsigned*)(ws + WS_CTL + CTL_BAR) + 15 * 4096);
        { const int idx = blockIdx.x * NTHR + F.tid;
          if (idx < NB * NMOD) { const int b = idx / NMOD, j = idx % NMOD; float s = b_ada[j];
#pragma unroll
              for (int kc = 0; kc < 4; ++kc) s += modp[(size_t)(kc * 4 + b) * NMOD + j];
              mod[idx] = s; } }
        LAS float* Am = (LAS float*)(F.lds + RING_OFF);
        LAS float* Sm = Am + DM;
        for (int rb = blockIdx.x; rb < MTOK / 64; rb += F.G) {
            const int b = (rb * 64) / SEQ;
            __syncthreads();
            for (int k = F.tid; k < DM; k += NTHR) { float sh = b_ada[k], sc = b_ada[DM + k];
#pragma unroll
                for (int kc = 0; kc < 4; ++kc) { sh += modp[(size_t)(kc * 4 + b) * NMOD + k]; sc += modp[(size_t)(kc * 4 + b) * NMOD + DM + k]; }
                Am[k] = norm_mix_w[k] * (1.f + sc); Sm[k] = sh; }
            __syncthreads();
            for (int r = F.wave; r < 64; r += 2 * NWAVES) {
                const int rowA = rb * 64 + r, rowB = rowA + NWAVES;
                const f32x4* xa = (const f32x4*)(x + (size_t)rowA * DM) + 2 * F.lane; const f32x4* xb = (const f32x4*)(x + (size_t)rowB * DM) + 2 * F.lane;
                f32x4 va[8], vb[8]; float sa = 0.f, sb = 0.f;
#pragma unroll
                for (int j = 0; j < 4; ++j) { va[2 * j] = xa[128 * j]; va[2 * j + 1] = xa[128 * j + 1]; vb[2 * j] = xb[128 * j]; vb[2 * j + 1] = xb[128 * j + 1]; }
#pragma unroll
                for (int j = 0; j < 8; ++j) { sa += (va[j].x * va[j].x + va[j].y * va[j].y) + (va[j].z * va[j].z + va[j].w * va[j].w); sb += (vb[j].x * vb[j].x + vb[j].y * vb[j].y) + (vb[j].z * vb[j].z + vb[j].w * vb[j].w); }
                const float ra = rsqrtf(wave_sum(sa) * (1.f / DM) + EPS), rbb = rsqrtf(wave_sum(sb) * (1.f / DM) + EPS);
                u32x4* oa = (u32x4*)(Hb + (size_t)rowA * DM) + F.lane; u32x4* ob = (u32x4*)(Hb + (size_t)rowB * DM) + F.lane;
#pragma unroll
                for (int j = 0; j < 4; ++j) { const int k = 8 * F.lane + 512 * j;
                    const f32x4 a0 = *(const LAS f32x4*)(Am + k), a1 = *(const LAS f32x4*)(Am + k + 4), s0 = *(const LAS f32x4*)(Sm + k), s1 = *(const LAS f32x4*)(Sm + k + 4);
                    const f32x4 p0 = va[2 * j] * ra * a0 + s0, p1 = va[2 * j + 1] * ra * a1 + s1, q0 = vb[2 * j] * rbb * a0 + s0, q1 = vb[2 * j + 1] * rbb * a1 + s1;
                    u32x4 w; w.x = pg8::cvt_pk_bf16(p0.x, p0.y); w.y = pg8::cvt_pk_bf16(p0.z, p0.w); w.z = pg8::cvt_pk_bf16(p1.x, p1.y); w.w = pg8::cvt_pk_bf16(p1.z, p1.w); oa[64 * j] = w;
                    u32x4 w2; w2.x = pg8::cvt_pk_bf16(q0.x, q0.y); w2.y = pg8::cvt_pk_bf16(q0.z, q0.w); w2.z = pg8::cvt_pk_bf16(q1.x, q1.y); w2.w = pg8::cvt_pk_bf16(q1.z, q1.w); ob[64 * j] = w2; }
            }
        }
        };
        auto do_conv = [&](const int i_lo, const int i_hi) {
        if (i_lo == 0) {
        { bf16_t* WRh = (bf16_t*)(ws + WS_WR); bf16_t* WRl = WRh + 48 * DM;
          for (int idx = blockIdx.x * NTHR + F.tid; idx < DM * 48; idx += F.G * NTHR) { const int j = idx / DM, k = idx - j * DM;
              float v = 0.f; if (j < 4) v = w_group[k * 4 + j]; else if (j < 36) v = w_router[((size_t)((j - 4) >> 3) * DM + k) * 8 + ((j - 4) & 7)];
              const unsigned hb = f2bf(v); WRh[idx] = (bf16_t)hb; WRl[idx] = (bf16_t)f2bf(v - __uint_as_float(hb << 16)); } }
        }
        { LAS float* scr = (LAS float*)(F.lds + RING_OFF + 4096 + F.wave * 8704);
          const int gw = F.vcu * NWAVES + F.wave, NGW = F.G * NWAVES;
          constexpr int I_IN = (DM / 64) * (INW / 32), I_OUT = (DM / 64) * (DM / 32), I_E13 = (DM / 64) * (DE / 32), I_E2 = (DE / 64) * (DM / 32);
          constexpr int NITEMS = I_IN + I_OUT + NE * (2 * I_E13);
#define P0_DECODE(d, it) do { int r = (it); \
              if (r < I_IN) { const int nblk = INW / 32, kb = r / nblk, nb = r % nblk; d = TrItem{w_in, Wt_in, INW, 64 * kb, 32 * nb, DM, (long)(32 * nb), 0.f}; } \
              else { r -= I_IN; if (r < I_OUT) { const int nblk = DM / 32, kb = r / nblk, nb = r % nblk; d = TrItem{w_out, Wt_out, DM, 64 * kb, 32 * nb, DM, (long)(32 * nb), 0.f}; } \
              else { r -= I_OUT; const int e = r / (2 * I_E13); r -= e * (2 * I_E13); const int which = r / I_E13; r -= which * I_E13; const int nblk = DE / 32, kb = r / nblk, nb = r % nblk, n0 = 32 * nb; \
                  d = TrItem{(which ? w3 : w1) + (size_t)e * DM * DE, W13t, DE, 64 * kb, n0, DM, (long)e * 1024 + (n0 >> 7) * 256 + which * 128 + (n0 & 127), W13_SCALE}; } } } while (0)
          { const long lo_ = (long)gw + (long)NGW * i_lo, hi_ = (long)gw + (long)NGW * i_hi; const int it0_ = lo_ < NITEMS ? (int)lo_ : NITEMS, ite_ = hi_ < NITEMS ? (int)hi_ : NITEMS;
            TR_STREAM(P0_DECODE, it0_, NGW, ite_); }
#undef P0_DECODE
          }
        };
        { const int isplit = (blockIdx.x & 1) ? 24 : 13;
          do_conv(0, isplit); __syncthreads(); do_rows(); __syncthreads(); do_conv(isplit, 1 << 20); }
        }
        if (BOTH(1)) GRID_BAR();
    }

    constexpr int W2_IE = (DE / 64) * (DM / 32), W2_NQ = NE * W2_IE, W2_SEAM = 2, W2_SEAMCAP = 256 * NWAVES * W2_SEAM;
#define W2_DECODE(d, it) do { const int e = (it) / W2_IE, r = (it) - e * W2_IE, nblk = DM / 32, kb = r / nblk, nb = r % nblk; \
        d = TrItem{w2 + (size_t)e * DE * DM, (unsigned char*)W2t + (size_t)e * DM * DE, DM, 64 * kb, 32 * nb, DE, (long)(32 * nb), W2_SCALE}; } while (0)
    if (IN(2)) {
        REFRESH();
        __syncthreads();
        pg8::DenseOrder S; S.init(MTOK, INW, DM, F.G, (int)blockIdx.x);
        pg8::EpiProj E{PROJ, kmean, (int*)(ws + WS_CTL + CTL_CNT + 8192)};
        pg8::gemm_phase<pg8::EpiProj, pg8::DenseOrder>(F.lds + RING_OFF, Hb, Wt_in, DM * 2, S, E);
#if PROBE_PHASE == 2
        {
        __syncthreads();
        pg8::DenseOrder S; S.init(MTOK, INW, DM, F.G, (int)blockIdx.x);
        pg8::EpiProj E{PROJ, nullptr, nullptr};
        pg8::gemm_phase<pg8::EpiProj, pg8::DenseOrder>(F.lds + RING_OFF, Hb, Wt_in, DM * 2, S, E);
        }
#endif
        if (BOTH(2)) { unsigned* bar2 = (unsigned*)(ws + WS_CTL + CTL_BAR) + 14 * 4096;
            xcd_arrive(bar, bar2);
            if (F.G * NWAVES * W2_SEAM == W2_SEAMCAP) { LAS float* scr = (LAS float*)(F.lds + RING_OFF + F.wave * 8704); const int gw_ = (int)blockIdx.x * NWAVES + F.wave;
                TR_STREAM(W2_DECODE, gw_ * W2_SEAM, 1, gw_ * W2_SEAM + W2_SEAM); }
            xcd_wait(bar, bar2); }
    }

    bf16_t* STb = (bf16_t*)(ws + WS_H);
    if (IN(3)) {
        REFRESH();
        __syncthreads();
        char* albs = (char*)lds_raw + RING_OFF;
        const float* kn2f = (const float*)(ws + WS_CTL + CTL_CNT + 8192);
        if (F.G == 256) {
            if (blockIdx.x < NQ_CH) { const int c = blockIdx.x, bh = (c & 7) * 2 + ((c >> 3) & 1); rt::kvchain_unit(bh >> 2, bh & 3, c >> 4, PROJ, STb, albs);
                asm volatile("s_waitcnt vmcnt(0)" ::: "memory"); __syncthreads();
                if (F.tid == 0) { __builtin_amdgcn_fence(__ATOMIC_RELEASE, "agent"); asm volatile("s_waitcnt vmcnt(0)" ::: "memory"); xb_add((unsigned*)(ws + WS_CTL + CTL_CNT) + 67, 1u); } }
            unsigned* qa = (unsigned*)(ws + WS_CTL + CTL_CNT) + 128; bool r3_ready = false;
#pragma unroll 1
            for (;;) {
                __syncthreads();
                if (F.tid == 0) F.MISC[0] = __hip_atomic_fetch_add(qa, 1u, __ATOMIC_RELAXED, __HIP_MEMORY_SCOPE_AGENT);
                __syncthreads();
                const int q = __builtin_amdgcn_readfirstlane((int)F.MISC[0]);
                if (q >= NQ_ATT + NQ_CH + NB * RH * 32) break;
                if (q >= NQ_ATT + NQ_CH) {
                    if (!r3_ready) { if (F.tid == 0) { unsigned* gc = (unsigned*)(ws + WS_CTL + CTL_CNT) + 67; unsigned sp = 0u;
                            while (xb_ld(gc) < (unsigned)NQ_CH) { __builtin_amdgcn_s_sleep(8); if (++sp > (1u << 22)) break; }
                            __builtin_amdgcn_fence(__ATOMIC_ACQUIRE, "agent"); asm volatile("s_waitcnt vmcnt(0)" ::: "memory"); }
                        __syncthreads(); r3_ready = true; }
                    const int u = q - (NQ_ATT + NQ_CH), bh = u >> 5, n = u & 31;
                    rt::ret_unit<0>(bh >> 2, bh & 3, n, PROJ, STb, args.in[6], ATT, albs, (float*)((char*)lds_raw + LDSCTL_OFF + 2048));
                    continue; }
                const int e = __builtin_amdgcn_readfirstlane((int)ATT_TAB.v[q]);
                if (e < NQ_ATT) { const int bh = e >> 4; mb::moba_unit(bh >> 3, bh & 7, e & 15, PROJ, kmean, kn2f, ATT, albs); }
            }
        }
        if (F.G != 256) {
#pragma unroll 1
            for (int u = blockIdx.x; u < NQ_ATT + NQ_CH; u += F.G) {
                if (u < NQ_ATT) { const int bh = u >> 4; mb::moba_unit(bh >> 3, bh & 7, 15 - (u & 15), PROJ, kmean, kn2f, ATT, albs); }
                else { const int v = u - NQ_ATT; const int bh = v / CH_PER; rt::kvchain_unit(bh >> 2, bh & 3, v % CH_PER, PROJ, STb, albs); }
            }
        }
        if (hi > 5 && F.G != 256) GRID_BAR();
    }
    if (IN(6)) {
        REFRESH();
        _Pragma("unroll 1") for (int rep_ = 0; rep_ < REPS(6); ++rep_) {
        __syncthreads();
        char* albs = (char*)lds_raw + RING_OFF;
        float* ssx = (float*)((char*)lds_raw + LDSCTL_OFF + 2048);
#pragma unroll 1
        for (int u = (F.G != 256 ? (int)blockIdx.x : NB * RH * 32); u < NB * RH * 32; u += F.G) { const int bh = u >> 5, n = u & 31; if (rep_ == 0) rt::ret_unit<0>(bh >> 2, bh & 3, n, PROJ, STb, args.in[6], ATT, albs, ssx); else rt::ret_unit<PROBE_STOP>(bh >> 2, bh & 3, n, PROJ, STb, args.in[6], ATT, albs, ssx); }
        }
        if (BOTH(6)) GRID_BAR();
    }

    if (IN(7)) {
        REFRESH();
        __syncthreads();
        pg8::DenseOrder S; S.init(MTOK, DM, DM, F.G, (int)blockIdx.x);
        pg8::EpiOut E{x, mod, (bf16_t*)(ws + WS_X1), (float*)(ws + WS_MODP)};
        pg8::gemm_phase<pg8::EpiOut, pg8::DenseOrder>(F.lds + RING_OFF, ATT, Wt_out, DM * 2, S, E);
#if PROBE_PHASE == 7
        {
        __syncthreads();
        pg8::DenseOrder S; S.init(MTOK, DM, DM, F.G, (int)blockIdx.x);
        pg8::EpiOut E{x, mod, (bf16_t*)(ws + WS_X1), (float*)(ws + WS_MODP)};
        pg8::gemm_phase<pg8::EpiOut, pg8::DenseOrder>(F.lds + RING_OFF, ATT, Wt_out, DM * 2, S, E);
        }
#endif
        if (BOTH(7)) GRID_BAR();
    }

    if (IN(8)) {
        REFRESH();
        _Pragma("unroll 1") for (int rep_ = 0; rep_ < REPS(8); ++rep_) {
        constexpr int LDB = 72;
        LAS float* A2 = (LAS float*)(F.lds + RING_OFF);
        LAS float* S2 = A2 + DM;
        LAS bf16_t* wt = (LAS bf16_t*)(S2 + DM);
        LAS float* lgt = (LAS float*)(wt + 2 * 2 * 48 * LDB);
        LAS float* rst = lgt + 64 * 48;
        LAS int* hist = (LAS int*)(rst + 64);
        LAS int* hbase = hist + 32;
        LAS int* tk = hbase + 32;
        const bf16_t* WRh = (const bf16_t*)(ws + WS_WR); const bf16_t* WRl = WRh + 48 * DM;
        const bf16_t* x1 = (const bf16_t*)(ws + WS_X1);
        const float* b_group = args.in[10]; const float* b_router = args.in[12]; const float* norm_ffn_w = args.in[8];
        int* cnt = (int*)(ws + WS_CTL + CTL_CNT); int* elist = (int*)(ws + WS_ELIST); float* elistw = (float*)(ws + WS_ELISTW); int* tokslot = (int*)(ws + WS_TOKSLOT);
        for (int rb = blockIdx.x; rb < MTOK / 64; rb += F.G) {
            const int b = (rb * 64) / SEQ;
            __syncthreads();
            const int tg = F.wave & 3, kh = F.wave >> 2;
            const int li = F.lane & 15, kq = F.lane >> 4, arow = rb * 64 + 16 * tg + li, ak = 32 * kh + 8 * kq;
            u32x4 xw = *(const u32x4*)(x1 + (size_t)arow * DM + ak);
            const int wcol = F.tid >> 3, wku = F.tid & 7;
            u32x4 wvh = {0u, 0u, 0u, 0u}, wvl = {0u, 0u, 0u, 0u};
            if (F.tid < 384) { wvh = *(const u32x4*)(WRh + (size_t)wcol * DM + wku * 8); wvl = *(const u32x4*)(WRl + (size_t)wcol * DM + wku * 8); }
            { const float* rowss = (const float*)(ws + WS_MODP);
              if (F.tid < 64) { const float* pr = rowss + rb * 64 + F.tid; float sq = 0.f;
#pragma unroll
                  for (int j = 0; j < 32; ++j) sq += pr[(size_t)j * MTOK];
                  rst[F.tid] = rsqrtf(sq * (1.f / DM) + EPS); } }
            for (int k = F.tid; k < DM; k += NTHR) { A2[k] = norm_ffn_w[k] * (1.f + mod[(size_t)b * NMOD + 4 * DM + k]); S2[k] = mod[(size_t)b * NMOD + 3 * DM + k]; }
            if (F.tid < 32) hist[F.tid] = 0;
            __syncthreads();
            f32x4 lacc[3];
#pragma unroll
            for (int ct = 0; ct < 3; ++ct) lacc[ct] = (f32x4){0.f, 0.f, 0.f, 0.f};
            const float rs = rst[16 * tg + li];
            for (int kt = 0; kt < DM / 64; ++kt) {
                const int k0 = kt * 64;
                const f32x4 xa = {__uint_as_float(xw.x << 16), __uint_as_float(xw.x & 0xffff0000u), __uint_as_float(xw.y << 16), __uint_as_float(xw.y & 0xffff0000u)};
                const f32x4 xb = {__uint_as_float(xw.z << 16), __uint_as_float(xw.z & 0xffff0000u), __uint_as_float(xw.w << 16), __uint_as_float(xw.w & 0xffff0000u)};
                const f32x4 a0 = *(const LAS f32x4*)(A2 + k0 + ak), a1 = *(const LAS f32x4*)(A2 + k0 + ak + 4), s0 = *(const LAS f32x4*)(S2 + k0 + ak), s1 = *(const LAS f32x4*)(S2 + k0 + ak + 4);
                const f32x4 h0 = xa * rs * a0 + s0, h1 = xb * rs * a1 + s1;
                { u32x2 w; w.x = cvt4_fp8(h0.x, h0.y, h0.z, h0.w); w.y = cvt4_fp8(h1.x, h1.y, h1.z, h1.w);
                  *(u32x2*)((unsigned char*)Hb + (size_t)arow * DM + k0 + ak) = w; }
                u32x4 ah, al;
                ah.x = pg8::cvt_pk_bf16(h0.x, h0.y); ah.y = pg8::cvt_pk_bf16(h0.z, h0.w); ah.z = pg8::cvt_pk_bf16(h1.x, h1.y); ah.w = pg8::cvt_pk_bf16(h1.z, h1.w);
                al.x = pg8::cvt_pk_bf16(h0.x - __uint_as_float(ah.x << 16), h0.y - __uint_as_float(ah.x & 0xffff0000u)); al.y = pg8::cvt_pk_bf16(h0.z - __uint_as_float(ah.y << 16), h0.w - __uint_as_float(ah.y & 0xffff0000u));
                al.z = pg8::cvt_pk_bf16(h1.x - __uint_as_float(ah.z << 16), h1.y - __uint_as_float(ah.z & 0xffff0000u)); al.w = pg8::cvt_pk_bf16(h1.z - __uint_as_float(ah.w << 16), h1.w - __uint_as_float(ah.w & 0xffff0000u));
                LAS bf16_t* wtb = wt + (kt & 1) * (2 * 48 * LDB);
                if (F.tid < 384) { *(LAS u32x4*)(wtb + wcol * LDB + wku * 8) = wvh; *(LAS u32x4*)(wtb + 48 * LDB + wcol * LDB + wku * 8) = wvl; }
                if (kt + 1 < DM / 64) { xw = *(const u32x4*)(x1 + (size_t)arow * DM + k0 + 64 + ak);
                    if (F.tid < 384) { wvh = *(const u32x4*)(WRh + (size_t)wcol * DM + k0 + 64 + wku * 8); wvl = *(const u32x4*)(WRl + (size_t)wcol * DM + k0 + 64 + wku * 8); } }
                __syncthreads();
                const bf16x8 av_h = *reinterpret_cast<const bf16x8*>(&ah), av_l = *reinterpret_cast<const bf16x8*>(&al);
#pragma unroll
                for (int ct = 0; ct < 3; ++ct) { const LAS bf16_t* bp = wtb + (16 * ct + li) * LDB + ak;
                    const bf16x8 bh_ = *(const LAS bf16x8*)bp, bl_ = *(const LAS bf16x8*)(bp + 48 * LDB);
                    lacc[ct] = __builtin_amdgcn_mfma_f32_16x16x32_bf16(av_h, bh_, lacc[ct], 0, 0, 0);
                    lacc[ct] = __builtin_amdgcn_mfma_f32_16x16x32_bf16(av_h, bl_, lacc[ct], 0, 0, 0);
                    lacc[ct] = __builtin_amdgcn_mfma_f32_16x16x32_bf16(av_l, bh_, lacc[ct], 0, 0, 0); }
            }
            __syncthreads();
            if (kh == 1) {
#pragma unroll
                for (int ct = 0; ct < 3; ++ct)
#pragma unroll
                    for (int r = 0; r < 4; ++r) lgt[(16 * tg + 4 * (F.lane >> 4) + r) * 48 + 16 * ct + (F.lane & 15)] = lacc[ct][r];
            }
            __syncthreads();
            if (kh == 0) {
#pragma unroll
                for (int ct = 0; ct < 3; ++ct)
#pragma unroll
                    for (int r = 0; r < 4; ++r) lgt[(16 * tg + 4 * (F.lane >> 4) + r) * 48 + 16 * ct + (F.lane & 15)] += lacc[ct][r];
            }
            __syncthreads();
            if (rep_ == 0) {
            if (F.tid < 64) {
                LAS float* lg = lgt + F.tid * 48; const int token = rb * 64 + F.tid;
                float g0 = lg[0] + b_group[0]; int gs = 0; float gl[4]; gl[0] = g0;
#pragma unroll
                for (int i = 1; i < 4; ++i) { gl[i] = lg[i] + b_group[i]; if (gl[i] > g0) { g0 = gl[i]; gs = i; } }
                float gsum = 0.f;
#pragma unroll
                for (int i = 0; i < 4; ++i) gsum += __expf(gl[i] - g0);
                const float gw = 1.f / gsum;
                LAS float* el = lg + 4 + gs * 8; const float* br = b_router + gs * 8;
                float em = -INFINITY;
#pragma unroll
                for (int i = 0; i < 8; ++i) { const float v = el[i] + br[i]; el[i] = v; em = fmaxf(em, v); }
                float esum = 0.f;
#pragma unroll
                for (int i = 0; i < 8; ++i) { const float pe = __expf(el[i] - em); el[i] = pe; esum += pe; }
                int i1 = 0; float p1 = el[0];
#pragma unroll
                for (int i = 1; i < 8; ++i) if (el[i] > p1) { p1 = el[i]; i1 = i; }
                int i2 = -1; float p2 = -1.f;
#pragma unroll
                for (int i = 0; i < 8; ++i) if (i != i1 && el[i] > p2) { p2 = el[i]; i2 = i; }
                p1 /= esum; p2 /= esum;
                const int e0 = gs * 8 + i1, e1 = gs * 8 + i2;
                const int q0 = __hip_atomic_fetch_add(&hist[e0], 1, __ATOMIC_RELAXED, __HIP_MEMORY_SCOPE_WORKGROUP), q1 = __hip_atomic_fetch_add(&hist[e1], 1, __ATOMIC_RELAXED, __HIP_MEMORY_SCOPE_WORKGROUP);
                tk[F.tid * 4 + 0] = e0; tk[F.tid * 4 + 1] = e1; tk[F.tid * 4 + 2] = q0; tk[F.tid * 4 + 3] = q1;
                lg[36] = gw * p1 / (p1 + p2); lg[37] = gw * p2 / (p1 + p2);
                (void)token;
            }
            __syncthreads();
            if (F.tid < 32) { const int n = hist[F.tid]; hbase[F.tid] = n ? atomicAdd(cnt + F.tid, n) : 0; }
            __syncthreads();
            if (F.tid < 128) { const int tl = F.tid >> 1, sl = F.tid & 1, token = rb * 64 + tl;
                const int e = tk[tl * 4 + sl], pos = hbase[e] + tk[tl * 4 + 2 + sl];
                elist[e * LCAP + pos] = token * 2 + sl; elistw[e * LCAP + pos] = lgt[tl * 48 + 36 + sl]; tokslot[token * 2 + sl] = (e << 16) | pos; }
            }
        }
        }
        if (BOTH(8)) GRID_BAR();
    }

    constexpr int MOE_OFF = LDSCTL_OFF + 1024;
    LAS int* mtabs = (LAS int*)(F.lds + MOE_OFF);
    if (IN(9) || IN(10) || IN(11)) {
        REFRESH();
        const int* cnt = (const int*)(ws + WS_CTL + CTL_CNT);
        __syncthreads();
        if (F.tid == 0) { int so = 0, st = 0; for (int e = 0; e < NE; ++e) { const int ce = cnt[e]; mtabs[e] = so; mtabs[33 + e] = st; so += ce; st += (ce + 255) >> 8; } mtabs[32] = so; mtabs[33 + 32] = st; }
        __syncthreads();
    }
    if (IN(9)) {
        REFRESH();
        _Pragma("unroll 1") for (int rep_ = 0; rep_ < REPS(9); ++rep_) {
        pg8::MoeOrder S{mtabs, (const int*)(ws + WS_CTL + CTL_CNT), (const int*)(ws + WS_ELIST), 4, DM, F.G, (int)blockIdx.x, 1, (size_t)1024 * DM};
        pg8::EpiAct E{(unsigned char*)(ws + WS_ATT)};
        pg8::gemm_phase<pg8::EpiAct, pg8::MoeOrder, true>(F.lds + RING_OFF, Hb, W13t, DM, S, E);
        if (rep_ == 0) {
            __syncthreads();
            LAS float* scr = (LAS float*)(F.lds + RING_OFF + F.wave * 8704);
            unsigned* qctr = (unsigned*)(ws + WS_CTL + CTL_CNT) + 64;
            const int base_ = (BOTH(2) && F.G * NWAVES * W2_SEAM == W2_SEAMCAP) ? W2_SEAMCAP : 0;
            for (;;) {
                int it0 = 0; if (F.lane == 0) it0 = (int)__hip_atomic_fetch_add(qctr, 16u, __ATOMIC_RELAXED, __HIP_MEMORY_SCOPE_AGENT);
                it0 = __builtin_amdgcn_readfirstlane(it0) + base_;
                if (it0 >= W2_NQ) break;
                TR_STREAM(W2_DECODE, it0, 1, it0 + 16);
            }
        }
        }
        if (BOTH(9)) GRID_BAR();
    }
    typedef int i32x2_t __attribute__((ext_vector_type(2)));
    i32x2_t ts[2]; u32x4 xw[2][4]; f32x4 wn[8]; bool p11pre = false;
    if (IN(10)) {
        REFRESH();
        pg8::MoeOrder S{mtabs, (const int*)(ws + WS_CTL + CTL_CNT), (const int*)(ws + WS_ELIST), 8, DE, F.G, (int)blockIdx.x, 0, (size_t)DM * DE};
        pg8::EpiY E{(unsigned char*)(ws + WS_PROJ), (const float*)(ws + WS_ELISTW)};
        pg8::gemm_phase<pg8::EpiY, pg8::MoeOrder, true>(F.lds + RING_OFF, (const void*)(ws + WS_ATT), W2t, DE, S, E);
#if PROBE_PHASE == 10
        {
        pg8::MoeOrder S{mtabs, (const int*)(ws + WS_CTL + CTL_CNT), (const int*)(ws + WS_ELIST), 8, DE, F.G, (int)blockIdx.x, 0, (size_t)DM * DE};
        pg8::EpiY E{(unsigned char*)(ws + WS_PROJ), (const float*)(ws + WS_ELISTW)};
        pg8::gemm_phase<pg8::EpiY, pg8::MoeOrder, true>(F.lds + RING_OFF, (const void*)(ws + WS_ATT), W2t, DE, S, E);
        }
#endif
        if (BOTH(10)) { const int gw_ = blockIdx.x * NWAVES + F.wave, NGW_ = F.G * NWAVES; const float* nfw_ = args.in[16];
#pragma unroll
            for (int j = 0; j < 4; ++j) { wn[2 * j] = *((const f32x4*)nfw_ + 2 * F.lane + 128 * j); wn[2 * j + 1] = *((const f32x4*)nfw_ + 2 * F.lane + 128 * j + 1); }
#pragma unroll
            for (int r = 0; r < 2; ++r) { const int rw = gw_ + r * NGW_ < MTOK ? gw_ + r * NGW_ : 0;
                const i32x2_t t_ = ((const i32x2_t*)(ws + WS_TOKSLOT))[rw]; ts[r].x = t_.x; ts[r].y = t_.y;
                const u32x4* xr = (const u32x4*)((const bf16_t*)(ws + WS_X1) + (size_t)rw * DM) + F.lane;
#pragma unroll
                for (int j = 0; j < 4; ++j) xw[r][j] = xr[64 * j]; }
            p11pre = true; }
        if (BOTH(10)) GRID_BAR();
    }
    if (IN(11)) {
        REFRESH();
        const int* tokslot = (const int*)(ws + WS_TOKSLOT); const bf16_t* Y = (const bf16_t*)(ws + WS_PROJ); const float* nfw = args.in[16];
        float* outp = args.out;
        const int gw = blockIdx.x * NWAVES + F.wave, NGW = F.G * NWAVES;
        typedef int i32x2 __attribute__((ext_vector_type(2)));
        const i32x2* ts2 = (const i32x2*)tokslot;
        _Pragma("unroll 1") for (int rep_ = 0; rep_ < REPS(11); ++rep_) {
        constexpr int NR = 2;
        static_assert(NR == 2, "the cross-barrier prefetch above loads two rows");
        f32x4 gc[8]; int gb = -1;
        if (!p11pre)
#pragma unroll
        for (int j = 0; j < 4; ++j) { wn[2 * j] = *((const f32x4*)nfw + 2 * F.lane + 128 * j); wn[2 * j + 1] = *((const f32x4*)nfw + 2 * F.lane + 128 * j + 1); }
        if (!p11pre)
#pragma unroll
        for (int r = 0; r < NR; ++r) { const i32x2 t_ = ts2[gw + r * NGW < MTOK ? gw + r * NGW : 0]; ts[r].x = t_.x; ts[r].y = t_.y; }
#pragma unroll 1
        for (int row = gw; row < MTOK; row += NR * NGW) {
            u32x2 ya[NR][4], yc[NR][4];
#pragma unroll
            for (int r = 0; r < NR; ++r) { const int rw = row + r * NGW < MTOK ? row + r * NGW : row;
                const size_t p0 = (size_t)(mtabs[ts[r].x >> 16] + (ts[r].x & 0xffff)), p1 = (size_t)(mtabs[ts[r].y >> 16] + (ts[r].y & 0xffff));
                const u32x4* xr = (const u32x4*)((const bf16_t*)(ws + WS_X1) + (size_t)rw * DM) + F.lane;
                const u32x2* y0 = (const u32x2*)((const unsigned char*)Y + p0 * DM) + F.lane; const u32x2* y1 = (const u32x2*)((const unsigned char*)Y + p1 * DM) + F.lane;
#pragma unroll
                for (int j = 0; j < 4; ++j) { if (!p11pre) xw[r][j] = xr[64 * j]; ya[r][j] = y0[64 * j]; yc[r][j] = y1[64 * j]; } }
            p11pre = false;
#pragma unroll
            for (int r = 0; r < NR; ++r) { const int nr = row + (NR + r) * NGW; const i32x2 t_ = ts2[nr < MTOK ? nr : row]; ts[r].x = t_.x; ts[r].y = t_.y; }
#pragma unroll
            for (int r = 0; r < NR; ++r) { const bool vr = row + r * NGW < MTOK; const int rw = vr ? row + r * NGW : row; const int b = rw / SEQ;
                if (b != gb) { const f32x4* gf = (const f32x4*)(mod + (size_t)b * NMOD + 5 * DM) + 2 * F.lane; gb = b;
#pragma unroll
                    for (int j = 0; j < 4; ++j) { gc[2 * j] = gf[128 * j]; gc[2 * j + 1] = gf[128 * j + 1]; } }
                f32x4 v[8]; float s = 0.f;
#pragma unroll
                for (int j = 0; j < 4; ++j) { const u32x4 xv = xw[r][j]; const u32x2 a = ya[r][j], c = yc[r][j]; const f32x4 g0 = gc[2 * j], g1 = gc[2 * j + 1];
#define BL(w) __uint_as_float((w) << 16)
#define BH(w) __uint_as_float((w) & 0xffff0000u)
                    const f32x4 x0 = {BL(xv.x), BH(xv.x), BL(xv.y), BH(xv.y)}, x1v = {BL(xv.z), BH(xv.z), BL(xv.w), BH(xv.w)};
#undef BL
#undef BH
                    const auto a0 = __builtin_amdgcn_cvt_pk_f32_fp8((int)a.x, false), a1 = __builtin_amdgcn_cvt_pk_f32_fp8((int)a.x, true), a2 = __builtin_amdgcn_cvt_pk_f32_fp8((int)a.y, false), a3 = __builtin_amdgcn_cvt_pk_f32_fp8((int)a.y, true);
                    const auto c0 = __builtin_amdgcn_cvt_pk_f32_fp8((int)c.x, false), c1 = __builtin_amdgcn_cvt_pk_f32_fp8((int)c.x, true), c2 = __builtin_amdgcn_cvt_pk_f32_fp8((int)c.y, false), c3 = __builtin_amdgcn_cvt_pk_f32_fp8((int)c.y, true);
                    const f32x4 yA = {a0[0] + c0[0], a0[1] + c0[1], a1[0] + c1[0], a1[1] + c1[1]}, yB = {a2[0] + c2[0], a2[1] + c2[1], a3[0] + c3[0], a3[1] + c3[1]};
                    v[2 * j] = x0 + g0 * yA; v[2 * j + 1] = x1v + g1 * yB;
                    s += (v[2 * j].x * v[2 * j].x + v[2 * j].y * v[2 * j].y) + (v[2 * j].z * v[2 * j].z + v[2 * j].w * v[2 * j].w);
                    s += (v[2 * j + 1].x * v[2 * j + 1].x + v[2 * j + 1].y * v[2 * j + 1].y) + (v[2 * j + 1].z * v[2 * j + 1].z + v[2 * j + 1].w * v[2 * j + 1].w); }
                const float rstd = rsqrtf(wave_sum(s) * (1.f / DM) + EPS);
                if (vr) { f32x4* orow = (f32x4*)(outp + (size_t)rw * DM) + 2 * F.lane;
#pragma unroll
                    for (int j = 0; j < 4; ++j) { orow[128 * j] = v[2 * j] * rstd * wn[2 * j]; orow[128 * j + 1] = v[2 * j + 1] * rstd * wn[2 * j + 1]; } } }
        }
        }
    }
#if defined(PROBE_EXTRA_BARS)
    for (int i = 0; i < PROBE_EXTRA_BARS; ++i) GRID_BAR();
#endif
#undef IN
#undef BOTH
#undef GRID_BAR
}

extern "C" void kernel_launch(void* const* d_in, const int* in_sizes, int n_in, void* d_out, int out_size, void* d_ws, size_t ws_size, hipStream_t stream) {
  static int grid = 0;
  if (grid == 0) {
    if (ws_size < WS_END || n_in != 17) { fprintf(stderr, "kernel_launch: ws too small (%zu < %zu) or n_in %d\n", ws_size, (size_t)WS_END, n_in); grid = -1; return; }
    int dev = 0, cus = 0, per_cu = 0;
    if (hipGetDevice(&dev) != hipSuccess || hipDeviceGetAttribute(&cus, hipDeviceAttributeMultiprocessorCount, dev) != hipSuccess) { grid = -1; return; }
    if (hipFuncSetAttribute((const void*)mk_fwd, hipFuncAttributeMaxDynamicSharedMemorySize, LDS_BYTES) != hipSuccess) { fprintf(stderr, "kernel_launch: hipFuncSetAttribute failed\n"); grid = -1; return; }
    if (hipOccupancyMaxActiveBlocksPerMultiprocessor(&per_cu, (const void*)mk_fwd, NTHR, LDS_BYTES) != hipSuccess || per_cu < 1) { fprintf(stderr, "kernel_launch: occupancy query says %d blocks/CU\n", per_cu); grid = -1; (void)hipGetLastError(); return; }
    grid = cus;
    fprintf(stderr, "kernel_launch: grid %d, occupancy %d/CU, ws %zu\n", grid, per_cu, ws_size);
  }
  if (grid < 0) return;
  char* ws = (char*)d_ws; float* out = (float*)d_out;
  hipMemsetAsync(ws + WS_CTL, 0, CTL_ZERO_BYTES, stream);
  Args a{};
  for (int i = 0; i < 17; ++i) a.in[i] = (const float*)d_in[i];
  a.out = out; a.ws = (unsigned char*)d_ws;
  a.ph_lo = 0; a.ph_hi = 12; a.li = 0;
  hipLaunchKernelGGL(mk_fwd, dim3(grid), dim3(NTHR), LDS_BYTES, stream, a);
}
```
